# Optimizing an MI355X kernel written in HIP

```python
import math
import jax
import jax.numpy as jnp
from jax import lax
import numpy as np

D_MODEL = 4096
BATCH = 2
SEQ = 8192
DEPTH = 4

CHUNK = 64
N_MIXERS = 2
N_RWKV = (DEPTH + N_MIXERS - 1) // N_MIXERS
N_S5 = DEPTH // N_MIXERS
N_VRES = max(N_RWKV - 1, 0)
D_FF = 3 * D_MODEL // 2
RMS_EPS = 1e-6
RWKV_HEAD = 64
RWKV_HEADS = D_MODEL // RWKV_HEAD
W_LORA = 128
A_LORA = 128
V_LORA = 96
G_LORA = 96
GN_EPS = 64e-5
S5_GROUP = 16
S5_GROUPS = D_MODEL // S5_GROUP
S5_STATE = 64
DT_MIN = 1e-3
DT_MAX = 1e-1
LAMBDA_RE_MAX = -1e-4

kernel_name = 'hybrid_rwkv7_s5_macaron_trunk'


def rms_norm(x, g):
    xf = x.astype(jnp.float32)
    y = xf * lax.rsqrt(jnp.mean(xf * xf, axis=-1, keepdims=True) + RMS_EPS)
    return (y * g.astype(jnp.float32)).astype(x.dtype)


def swiglu(h, w_in, w_out):
    gate, up = jnp.split(h @ w_in, 2, axis=-1)
    return (jax.nn.silu(gate) * up) @ w_out


def token_shift(h):
    return jnp.pad(h, ((0, 0), (1, 0), (0, 0)))[:, :-1]


def rwkv7_recurrence(r, w, k, v, kk, a):
    def step(S, inp):
        r_t, w_t, k_t, v_t, kk_t, a_t = inp
        s_kk = jnp.einsum('bhvk,bhk->bhv', S, kk_t)
        S = (S * w_t[:, :, None, :]
             - s_kk[..., None] * (kk_t * a_t)[:, :, None, :]
             + v_t[..., None] * k_t[:, :, None, :])
        return S, jnp.einsum('bhvk,bhk->bhv', S, r_t)
    bsz, _, n_heads, n = r.shape
    xs = (jnp.moveaxis(r, 1, 0), jnp.moveaxis(w, 1, 0), jnp.moveaxis(k, 1, 0),
          jnp.moveaxis(v, 1, 0), jnp.moveaxis(kk, 1, 0), jnp.moveaxis(a, 1, 0))
    s0 = jnp.zeros((bsz, n_heads, n, n), jnp.float32)
    _, ys = lax.scan(step, s0, xs)
    return jnp.moveaxis(ys, 0, 1)


def rwkv7_mix(h, v_first, mu, w_rkv, w_o, w0, w_l1, w_l2, a0, a_l1, a_l2,
              g_l1, g_l2, k_k, k_a, r_k, ln_w, ln_b, v_res):
    f32 = jnp.float32
    bsz, t, d = h.shape
    H, N = RWKV_HEADS, RWKV_HEAD
    dx = token_shift(h) - h
    x_rkv = h[None] + dx[None] * mu[:3, None, None, :]
    r, k, v = jnp.einsum('cbtd,cde->cbte', x_rkv, w_rkv)
    xw = h + dx * mu[3]
    xa = h + dx * mu[4]
    xg = h + dx * mu[5]
    log_w = -jax.nn.softplus(-(w0 + jnp.tanh(xw @ w_l1) @ w_l2).astype(f32)) - 0.5
    decay = jnp.exp(-jnp.exp(log_w))
    a = jax.nn.sigmoid((a0 + (xa @ a_l1) @ a_l2).astype(f32))
    g = jax.nn.sigmoid(xg @ g_l1) @ g_l2
    if v_res is None:
        v_first = v
    else:
        v0, v_l1, v_l2 = v_res
        v = v + (v_first - v) * jax.nn.sigmoid(v0 + (x_rkv[2] @ v_l1) @ v_l2)

    def heads(z):
        return z.astype(f32).reshape(bsz, t, H, N)

    rh, vh, ah, wh = heads(r), heads(v), heads(a), heads(decay)
    kkh = heads(k * k_k)
    kkh = kkh / jnp.maximum(jnp.sqrt(jnp.sum(kkh * kkh, axis=-1, keepdims=True)), 1e-12)
    kh = heads(k) * (1.0 + (ah - 1.0) * k_a.astype(f32).reshape(H, N))
    y = rwkv7_recurrence(rh, wh, kh, vh, kkh, ah)
    mean = jnp.mean(y, axis=-1, keepdims=True)
    var = jnp.mean(jnp.square(y - mean), axis=-1, keepdims=True)
    y = ((y - mean) * lax.rsqrt(var + GN_EPS)).reshape(bsz, t, d)
    y = y * ln_w.astype(f32) + ln_b.astype(f32)
    bonus = jnp.sum(rh * kh * r_k.astype(f32), axis=-1, keepdims=True) * vh
    y = y + bonus.reshape(bsz, t, d)
    return (y.astype(h.dtype) * g) @ w_o, v_first


def _complex_combine(e_i, e_j):
    (ai_re, ai_im), (bi_re, bi_im) = e_i
    (aj_re, aj_im), (bj_re, bj_im) = e_j
    return ((aj_re * ai_re - aj_im * ai_im, aj_re * ai_im + aj_im * ai_re),
            (aj_re * bi_re - aj_im * bi_im + bj_re, aj_re * bi_im + aj_im * bi_re + bj_im))


def s5_mix(u, lam_re, lam_im, log_step, b_re, b_im, c_re, c_im, d_skip, w_glu):
    f32 = jnp.float32
    bsz, t, d = u.shape
    G, P, L, C = S5_GROUPS, S5_STATE, CHUNK, S5_GROUP
    lr = jnp.minimum(lam_re.astype(f32), LAMBDA_RE_MAX)
    li = lam_im.astype(f32)
    dt = jnp.exp(log_step.astype(f32))[:, None]
    ldt_re, ldt_im = lr * dt, li * dt
    mag = jnp.exp(ldt_re)
    ab_re, ab_im = mag * jnp.cos(ldt_im), mag * jnp.sin(ldt_im)
    den = lr * lr + li * li
    q_re = ((ab_re - 1.0) * lr + ab_im * li) / den
    q_im = (ab_im * lr - (ab_re - 1.0) * li) / den
    br, bi = b_re.astype(f32), b_im.astype(f32)
    bb_re = q_re[..., None] * br - q_im[..., None] * bi
    bb_im = q_re[..., None] * bi + q_im[..., None] * br
    cr, ci = c_re.astype(f32), c_im.astype(f32)
    dsk = d_skip.astype(f32).reshape(G, C)
    pos = jnp.arange(1, L + 1, dtype=f32)[:, None, None]
    pmag = jnp.exp(pos * ldt_re)
    pw_re, pw_im = pmag * jnp.cos(pos * ldt_im), pmag * jnp.sin(pos * ldt_im)
    a_re = jnp.broadcast_to(ab_re, (bsz, L, G, P))
    a_im = jnp.broadcast_to(ab_im, (bsz, L, G, P))

    def chunk_step(carry, u_c):
        s_re, s_im = carry
        ug = u_c.reshape(bsz, L, G, C)
        bu_re = jnp.einsum('gpc,blgc->blgp', bb_re, ug)
        bu_im = jnp.einsum('gpc,blgc->blgp', bb_im, ug)
        _, (x_re, x_im) = lax.associative_scan(
            _complex_combine, ((a_re, a_im), (bu_re, bu_im)), axis=1)
        x_re = x_re + pw_re * s_re[:, None] - pw_im * s_im[:, None]
        x_im = x_im + pw_re * s_im[:, None] + pw_im * s_re[:, None]
        y = (jnp.einsum('gcp,blgp->blgc', cr, x_re)
             - jnp.einsum('gcp,blgp->blgc', ci, x_im)
             + dsk * ug)
        return (x_re[:, -1], x_im[:, -1]), y.reshape(bsz, L, d)

    u_chunks = jnp.moveaxis(u.astype(f32).reshape(bsz, t // L, L, d), 1, 0)
    s0 = (jnp.zeros((bsz, G, P), f32), jnp.zeros((bsz, G, P), f32))
    _, ys = lax.scan(chunk_step, s0, u_chunks)
    y = jnp.moveaxis(ys, 0, 1).reshape(bsz, t, d)
    val, gate = jnp.split(jax.nn.gelu(y).astype(u.dtype) @ w_glu, 2, axis=-1)
    return val * jax.nn.sigmoid(gate)


def setup_inputs(seed: int = 0) -> dict:
    key = jax.random.key(seed)
    ks = iter(jax.random.split(key, 48))
    f32 = jnp.float32

    def nrm(shape, scale):
        return scale * jax.random.normal(next(ks), shape, f32)

    def uni(shape, lo, hi):
        return jax.random.uniform(next(ks), shape, f32, lo, hi)

    D, F = D_MODEL, D_FF
    NR, NS, NV = N_RWKV, N_S5, N_VRES
    H, N, G, P, C = RWKV_HEADS, RWKV_HEAD, S5_GROUPS, S5_STATE, S5_GROUP
    n_idx = jnp.arange(P, dtype=f32)
    return {
        'x': nrm((BATCH, SEQ, D), 1.0),
        'ffn_norm': 1.0 + nrm((DEPTH, 2, D), 0.02),
        'ffn_w_in': nrm((DEPTH, 2, D, 2 * F), D ** -0.5),
        'ffn_w_out': nrm((DEPTH, 2, F, D), F ** -0.5),
        'mix_norm': 1.0 + nrm((DEPTH, D), 0.02),
        'rwkv_mu': uni((NR, 6, D), 0.0, 1.0),
        'rwkv_w_rkv': nrm((NR, 3, D, D), D ** -0.5),
        'rwkv_w_o': nrm((NR, D, D), D ** -0.5),
        'rwkv_w0': uni((NR, D), -6.0, -1.0),
        'rwkv_w_l1': nrm((NR, D, W_LORA), D ** -0.5),
        'rwkv_w_l2': nrm((NR, W_LORA, D), 0.1 * W_LORA ** -0.5),
        'rwkv_a0': nrm((NR, D), 0.1),
        'rwkv_a_l1': nrm((NR, D, A_LORA), D ** -0.5),
        'rwkv_a_l2': nrm((NR, A_LORA, D), 0.3 * A_LORA ** -0.5),
        'rwkv_v0': 1.0 + nrm((NV, D), 0.1),
        'rwkv_v_l1': nrm((NV, D, V_LORA), D ** -0.5),
        'rwkv_v_l2': nrm((NV, V_LORA, D), 0.3 * V_LORA ** -0.5),
        'rwkv_g_l1': nrm((NR, D, G_LORA), D ** -0.5),
        'rwkv_g_l2': nrm((NR, G_LORA, D), G_LORA ** -0.5),
        'rwkv_k_k': 0.85 + nrm((NR, D), 0.02),
        'rwkv_k_a': 1.0 + nrm((NR, D), 0.02),
        'rwkv_r_k': nrm((NR, H, N), 0.1),
        'rwkv_ln_w': 1.0 + nrm((NR, D), 0.02),
        'rwkv_ln_b': nrm((NR, D), 0.02),
        's5_lam_re': -0.5 + nrm((NS, G, P), 0.01),
        's5_lam_im': math.pi * n_idx + nrm((NS, G, P), 0.01),
        's5_log_step': uni((NS, G), math.log(DT_MIN), math.log(DT_MAX)),
        's5_b_re': nrm((NS, G, P, C), (2 * C) ** -0.5),
        's5_b_im': nrm((NS, G, P, C), (2 * C) ** -0.5),
        's5_c_re': nrm((NS, G, C, P), 2 ** -0.5),
        's5_c_im': nrm((NS, G, C, P), 2 ** -0.5),
        's5_d': nrm((NS, D), 1.0),
        's5_w_glu': nrm((NS, D, 2 * D), D ** -0.5),
        'final_norm': 1.0 + nrm((D,), 0.02),
    }


def reference(x, ffn_norm, ffn_w_in, ffn_w_out, mix_norm,
              rwkv_mu, rwkv_w_rkv, rwkv_w_o, rwkv_w0, rwkv_w_l1, rwkv_w_l2,
              rwkv_a0, rwkv_a_l1, rwkv_a_l2, rwkv_v0, rwkv_v_l1, rwkv_v_l2,
              rwkv_g_l1, rwkv_g_l2, rwkv_k_k, rwkv_k_a, rwkv_r_k, rwkv_ln_w, rwkv_ln_b,
              s5_lam_re, s5_lam_im, s5_log_step, s5_b_re, s5_b_im, s5_c_re, s5_c_im,
              s5_d, s5_w_glu, final_norm):
    v_first = None
    for i in range(DEPTH):
        x = x + 0.5 * swiglu(rms_norm(x, ffn_norm[i, 0]), ffn_w_in[i, 0], ffn_w_out[i, 0])
        h = rms_norm(x, mix_norm[i])
        j = i // N_MIXERS
        if i % N_MIXERS == 0:
            v_res = None if j == 0 else (rwkv_v0[j - 1], rwkv_v_l1[j - 1], rwkv_v_l2[j - 1])
            y, v_first = rwkv7_mix(h, v_first, rwkv_mu[j], rwkv_w_rkv[j], rwkv_w_o[j],
                                   rwkv_w0[j], rwkv_w_l1[j], rwkv_w_l2[j],
                                   rwkv_a0[j], rwkv_a_l1[j], rwkv_a_l2[j],
                                   rwkv_g_l1[j], rwkv_g_l2[j], rwkv_k_k[j], rwkv_k_a[j],
                                   rwkv_r_k[j], rwkv_ln_w[j], rwkv_ln_b[j], v_res)
        else:
            y = s5_mix(h, s5_lam_re[j], s5_lam_im[j], s5_log_step[j], s5_b_re[j], s5_b_im[j],
                       s5_c_re[j], s5_c_im[j], s5_d[j], s5_w_glu[j])
        x = x + y
        x = x + 0.5 * swiglu(rms_norm(x, ffn_norm[i, 1]), ffn_w_in[i, 1], ffn_w_out[i, 1])
    return rms_norm(x, final_norm)
```

```cpp
#include <hip/hip_runtime.h>
#include <cstdio>
#include <cstdint>
#define REPX(n, ...) do { if constexpr ((n) >= 1) { __VA_ARGS__; } if constexpr ((n) >= 2) { __VA_ARGS__; } if constexpr ((n) >= 3) { __VA_ARGS__; } } while (0)
#ifndef REP_G1
#define REP_G1 1
#endif
#ifndef REP_G2DRY
#define REP_G2DRY 0
#endif
#ifndef REP_REC
#define REP_REC 1
#endif
#ifndef REP_PREP
#define REP_PREP 1
#endif
#ifndef REP_PRO
#define REP_PRO 1
#endif
#ifndef REP_RMISC
#define REP_RMISC 1
#endif
#ifndef REP_S5
#define REP_S5 1
#endif

#define GAS __attribute__((address_space(1)))
#define LAS __attribute__((address_space(3)))
#define PG8_LAS __attribute__((address_space(3)))

constexpr int BATCH = 2, T = 8192, D = 4096, M = BATCH * T, DEPTH = 4, FF = 6144;
constexpr int NH = 64, HN = 64;
constexpr int G5 = 256, P5 = 64, C5 = 16;
constexpr int WL = 128, AL = 128, VL = 96, GL = 96;
constexpr float RMS_EPS = 1e-6f, GN_EPS = 64e-5f;
constexpr int NWAVES = 8;
constexpr int SSPW = 128;

namespace pg8 {
typedef unsigned short bf16_t;
typedef short bf16x8 __attribute__((ext_vector_type(8)));
typedef float f32x4 __attribute__((ext_vector_type(4)));
typedef unsigned u32x4 __attribute__((ext_vector_type(4)));
constexpr int BM = 256, BK = 64, HALF = 128, HTB = HALF * BK * 2  , STAGE_BYTES = 8 * HTB, NXCD = 8, WGM = 8;

__host__ __device__ __forceinline__ int lds_byte(int r, int c) { const int st = (r >> 4) * 2 + (c >> 5), rr = r & 15, cc = c & 31, ob = rr * 64 + cc * 2; return st * 1024 + (ob ^ (((ob >> 9) & 1) << 5)); }
__host__ __device__ __forceinline__ void stage_rc(int b, int& R, int& C) { const int st = b / 1024, sb = b % 1024, swz = sb ^ (((sb >> 9) & 1) << 5); R = (st >> 1) * 16 + swz / 64; C = (st & 1) * 32 + (swz % 64) / 2; }
__host__ __device__ __forceinline__ int perm32(int rho) { const int n = rho >> 4, i = rho & 15; return 8 * (i >> 2) + 4 * n + (i & 3); }

struct Unit { int pm, pn, z; };
struct Gemm { const bf16_t* A; const bf16_t* Bt; int M, N, K, nz; size_t sAz, sBz; };

struct StaticOrder {
    int nM, nN, nwg, G, c, nz;
    __host__ __device__ void init(int M_, int N_, int nz_, int G_, int c_) { nM = M_ / BM; nN = N_ / BM; nwg = nM * nN; G = G_; c = c_; nz = nz_; }
    __host__ __device__ bool next(int i, Unit& u) const {
        const long L = (long)i * G + c; if (L >= (long)nwg * nz) return false;
        u.z = (int)(L / nwg);
        int wgid = (int)(L % nwg); { const int q = nwg / NXCD, r = nwg % NXCD, xcd = wgid % NXCD, off = wgid / NXCD; wgid = (xcd < r ? xcd * (q + 1) : r * (q + 1) + (xcd - r) * q) + off; }
        const int nig = WGM * nN, gid = wgid / nig, fm = gid * WGM, gsz = (nM - fm) < WGM ? (nM - fm) : WGM;
        u.pm = fm + ((wgid % nig) % gsz); u.pn = (wgid % nig) / gsz; return true;
    }
    __device__ __forceinline__ void a_ready(const Unit&) const {}
    __device__ __forceinline__ void done(const Unit&) const {}
};

typedef __bf16 bf16pair_t __attribute__((ext_vector_type(2)));
__device__ __forceinline__ unsigned cvt_pk_bf16(float lo, float hi) { bf16pair_t v; v[0] = (__bf16)lo; v[1] = (__bf16)hi; return __builtin_bit_cast(unsigned, v); }
__device__ __forceinline__ float fast_sigmoid(float x) { return __builtin_amdgcn_rcpf(1.0f + __builtin_amdgcn_exp2f(-1.44269504f * x)); }
__device__ __forceinline__ float sum4(const f32x4 v) { return (v[0] + v[1]) + (v[2] + v[3]); }
__device__ __forceinline__ float sq4(const f32x4 v) { return (v[0] * v[0] + v[1] * v[1]) + (v[2] * v[2] + v[3] * v[3]); }

struct EpiStore {
    static constexpr bool PERM = true, AFTER_DRAIN = false;
    float* o0; float* o1; float* o2; float* o3; int ldc; const float* bias; int bias_stride;
    __device__ __forceinline__ void operator()(const f32x4 (&acc)[2][2][4][2], const Unit& u, int wr, int wc, int fr, int fq) const {
        float* O = u.z == 0 ? o0 : (u.z == 1 ? o1 : (u.z == 2 ? o2 : o3));
        const int row0 = u.pm * BM + wr * 64 + fr, col0 = u.pn * BM + wc * 32 + 8 * fq;
        f32x4 bv[2][2];
#pragma unroll
        for (int bj = 0; bj < 2; ++bj)
#pragma unroll
            for (int n = 0; n < 2; ++n) bv[bj][n] = bias ? *(const f32x4*)(bias + (size_t)u.z * bias_stride + col0 + bj * HALF + 4 * n) : (f32x4){0.f, 0.f, 0.f, 0.f};
#pragma unroll
        for (int ai = 0; ai < 2; ++ai)
#pragma unroll
            for (int m = 0; m < 4; ++m) { float* rowp = O + (size_t)(row0 + ai * HALF + m * 16) * ldc + col0;
#pragma unroll
                for (int bj = 0; bj < 2; ++bj) { *(f32x4*)(rowp + bj * HALF) = acc[ai][bj][m][0] + bv[bj][0]; *(f32x4*)(rowp + bj * HALF + 4) = acc[ai][bj][m][1] + bv[bj][1]; } }
    }
};
struct EpiAct {
    static constexpr bool PERM = true, AFTER_DRAIN = false;
    bf16_t* o0; bf16_t* o1; bf16_t* o2; bf16_t* o3; int ldc; const float* bias; int bias_stride; int m0, m1, m2, m3;
    __device__ __forceinline__ static float act(float x, int mode) {
        if (mode == 1) return fast_sigmoid(x);
        if (mode == 2) { const float zz = -x, sp = fmaxf(zz, 0.f) + __builtin_amdgcn_logf(1.0f + __builtin_amdgcn_exp2f(-1.44269504f * fabsf(zz))) * 0.69314718f; return -__builtin_amdgcn_exp2f(1.44269504f * (-sp - 0.5f)); }
        return x;
    }
    __device__ __forceinline__ void operator()(const f32x4 (&acc)[2][2][4][2], const Unit& u, int wr, int wc, int fr, int fq) const {
        bf16_t* O = u.z == 0 ? o0 : (u.z == 1 ? o1 : (u.z == 2 ? o2 : o3)); const int mode = u.z == 0 ? m0 : (u.z == 1 ? m1 : (u.z == 2 ? m2 : m3));
        const int row0 = u.pm * BM + wr * 64 + fr, col0 = u.pn * BM + wc * 32 + 8 * fq;
        f32x4 bv[2][2];
#pragma unroll
        for (int bj = 0; bj < 2; ++bj)
#pragma unroll
            for (int n = 0; n < 2; ++n) bv[bj][n] = bias ? *(const f32x4*)(bias + (size_t)u.z * bias_stride + col0 + bj * HALF + 4 * n) : (f32x4){0.f, 0.f, 0.f, 0.f};
#pragma unroll
        for (int ai = 0; ai < 2; ++ai)
#pragma unroll
            for (int m = 0; m < 4; ++m) { bf16_t* rowp = O + (size_t)(row0 + ai * HALF + m * 16) * ldc + col0;
#pragma unroll
                for (int bj = 0; bj < 2; ++bj) { const f32x4 v0 = acc[ai][bj][m][0] + bv[bj][0], v1 = acc[ai][bj][m][1] + bv[bj][1];
                    float o0 = v0[0], o1 = v0[1], o2 = v0[2], o3 = v0[3], o4 = v1[0], o5 = v1[1], o6 = v1[2], o7 = v1[3];
                    if (mode == 1) { o0 = fast_sigmoid(o0); o1 = fast_sigmoid(o1); o2 = fast_sigmoid(o2); o3 = fast_sigmoid(o3); o4 = fast_sigmoid(o4); o5 = fast_sigmoid(o5); o6 = fast_sigmoid(o6); o7 = fast_sigmoid(o7); }
                    else if (mode == 2) { o0 = act(o0, 2); o1 = act(o1, 2); o2 = act(o2, 2); o3 = act(o3, 2); o4 = act(o4, 2); o5 = act(o5, 2); o6 = act(o6, 2); o7 = act(o7, 2); }
                    u32x4 w; w.x = cvt_pk_bf16(o0, o1); w.y = cvt_pk_bf16(o2, o3); w.z = cvt_pk_bf16(o4, o5); w.w = cvt_pk_bf16(o6, o7);
                    *(u32x4*)(rowp + bj * HALF) = w; } }
    }
};
__device__ __forceinline__ float row_rstd(const float* ssp, int nssp, int row, int fq) {
    const float* sp = ssp + (size_t)row * SSPW + fq * (nssp >> 2); float s = 0.f;
    for (int q = 0; q < (nssp >> 4); ++q) s += sum4(*(const f32x4*)(sp + 4 * q));
    s += __shfl_xor(s, 16); s += __shfl_xor(s, 32);
    return __builtin_amdgcn_rsqf(s * (1.0f / D) + RMS_EPS);
}
struct EpiSwiglu {
    static constexpr bool PERM = true, AFTER_DRAIN = false;
    bf16_t* O; int ldc; const float* ssp; int nssp; const PG8_LAS float* rsl; int pm0;
    __device__ __forceinline__ void operator()(const f32x4 (&acc)[2][2][4][2], const Unit& u, int wr, int wc, int fr, int fq) const {
        const int row0 = u.pm * BM + wr * 64 + fr, col0 = u.pn * HALF + wc * 32 + 8 * fq;
        float rsv[2][4];
        if (u.pm == pm0) {
#pragma unroll
            for (int ai = 0; ai < 2; ++ai)
#pragma unroll
                for (int m = 0; m < 4; ++m) rsv[ai][m] = rsl[wr * 64 + fr + ai * HALF + m * 16];
        } else {
#pragma unroll
            for (int ai = 0; ai < 2; ++ai)
#pragma unroll
                for (int m = 0; m < 4; ++m) rsv[ai][m] = row_rstd(ssp, nssp, row0 + ai * HALF + m * 16, fq);
        }
#pragma unroll
        for (int ai = 0; ai < 2; ++ai)
#pragma unroll
            for (int m = 0; m < 4; ++m) { const int row = row0 + ai * HALF + m * 16; const float rs = rsv[ai][m];
                float o[8];
#pragma unroll
                for (int n = 0; n < 2; ++n)
#pragma unroll
                    for (int e = 0; e < 4; ++e) { const float g = acc[ai][0][m][n][e] * rs, up = acc[ai][1][m][n][e] * rs; o[4 * n + e] = g * fast_sigmoid(g) * up; }
                u32x4 w; w.x = cvt_pk_bf16(o[0], o[1]); w.y = cvt_pk_bf16(o[2], o[3]); w.z = cvt_pk_bf16(o[4], o[5]); w.w = cvt_pk_bf16(o[6], o[7]);
                *(u32x4*)(O + (size_t)row * ldc + col0) = w; }
    }
};
__device__ __forceinline__ float bflo(unsigned u) { return __uint_as_float(u << 16); }
__device__ __forceinline__ float bfhi(unsigned u) { return __uint_as_float(u & 0xffff0000u); }
struct EpiResid {
    static constexpr bool PERM = true, AFTER_DRAIN = false;
    bf16_t* XB; float* ssp; float scale;
    __device__ __forceinline__ void operator()(const f32x4 (&acc)[2][2][4][2], const Unit& u, int wr, int wc, int fr, int fq) const {
        const int row0 = u.pm * BM + wr * 64 + fr, col0 = u.pn * BM + wc * 32 + 8 * fq;
#pragma unroll
        for (int ai = 0; ai < 2; ++ai) {
            u32x4 xv[4][2];
#pragma unroll
            for (int m = 0; m < 4; ++m)
#pragma unroll
                for (int bj = 0; bj < 2; ++bj) xv[m][bj] = *(const u32x4*)(XB + (size_t)(row0 + ai * HALF + m * 16) * D + col0 + bj * HALF);
#pragma unroll
            for (int m = 0; m < 4; ++m) { const int row = row0 + ai * HALF + m * 16; float ss = 0.f;
#pragma unroll
                for (int bj = 0; bj < 2; ++bj) { const u32x4 xr = xv[m][bj];
                    const f32x4 x0 = (f32x4){bflo(xr.x), bfhi(xr.x), bflo(xr.y), bfhi(xr.y)} + acc[ai][bj][m][0] * scale, x1 = (f32x4){bflo(xr.z), bfhi(xr.z), bflo(xr.w), bfhi(xr.w)} + acc[ai][bj][m][1] * scale;
                    ss += sq4(x0) + sq4(x1);
                    u32x4 w; w.x = cvt_pk_bf16(x0[0], x0[1]); w.y = cvt_pk_bf16(x0[2], x0[3]); w.z = cvt_pk_bf16(x1[0], x1[1]); w.w = cvt_pk_bf16(x1[2], x1[3]);
                    *(u32x4*)(XB + (size_t)row * D + col0 + bj * HALF) = w; }
                ss += __shfl_xor(ss, 16); ss += __shfl_xor(ss, 32);
                if (fq == 0) ssp[(size_t)row * SSPW + u.pn * 4 + wc] = ss; }
        }
    }
};
struct EpiGluResid {
    static constexpr bool PERM = true, AFTER_DRAIN = false;
    bf16_t* XB; float* ssp;
    __device__ __forceinline__ void operator()(const f32x4 (&acc)[2][2][4][2], const Unit& u, int wr, int wc, int fr, int fq) const {
        const int row0 = u.pm * BM + wr * 64 + fr, col0 = u.pn * HALF + wc * 32 + 8 * fq;
        u32x4 xv[2][4];
#pragma unroll
        for (int ai = 0; ai < 2; ++ai)
#pragma unroll
            for (int m = 0; m < 4; ++m) xv[ai][m] = *(const u32x4*)(XB + (size_t)(row0 + ai * HALF + m * 16) * D + col0);
#pragma unroll
        for (int ai = 0; ai < 2; ++ai)
#pragma unroll
            for (int m = 0; m < 4; ++m) { const int row = row0 + ai * HALF + m * 16; const u32x4 xr = xv[ai][m];
                f32x4 x0 = (f32x4){bflo(xr.x), bfhi(xr.x), bflo(xr.y), bfhi(xr.y)}, x1 = (f32x4){bflo(xr.z), bfhi(xr.z), bflo(xr.w), bfhi(xr.w)};
#pragma unroll
                for (int e = 0; e < 4; ++e) { x0[e] += acc[ai][0][m][0][e] * fast_sigmoid(acc[ai][1][m][0][e]); x1[e] += acc[ai][0][m][1][e] * fast_sigmoid(acc[ai][1][m][1][e]); }
                float ss = sq4(x0) + sq4(x1);
                u32x4 w; w.x = cvt_pk_bf16(x0[0], x0[1]); w.y = cvt_pk_bf16(x0[2], x0[3]); w.z = cvt_pk_bf16(x1[0], x1[1]); w.w = cvt_pk_bf16(x1[2], x1[3]);
                *(u32x4*)(XB + (size_t)row * D + col0) = w;
                ss += __shfl_xor(ss, 16); ss += __shfl_xor(ss, 32);
                if (fq == 0) ssp[(size_t)row * SSPW + u.pn * 4 + wc] = ss; }
    }
};
struct EpiDry {
    static constexpr bool PERM = true, AFTER_DRAIN = false;
    float* X;
    __device__ __forceinline__ void operator()(const f32x4 (&acc)[2][2][4][2], const Unit& u, int wr, int wc, int fr, int fq) const {
        float s = 0.f;
#pragma unroll
        for (int ai = 0; ai < 2; ++ai)
#pragma unroll
            for (int bj = 0; bj < 2; ++bj)
#pragma unroll
                for (int m = 0; m < 4; ++m) { s += sum4(acc[ai][bj][m][0]); s += sum4(acc[ai][bj][m][1]); }
        if (s == 1234.56789f) X[u.pm] = s;
    }
};
template <class Epi, class Sched, bool ALIGN_EPI = false, bool SP2 = false>
__device__ __forceinline__ void gemm_phase(PG8_LAS unsigned char* lds, const Gemm g, const Sched& S, const Epi& E) {
    const int tid = threadIdx.x, wid = __builtin_amdgcn_readfirstlane(tid >> 6), lane = tid & 63, wr = wid >> 2, wc = wid & 3, fr = lane & 15, fq = lane >> 4;
    const int K = g.K, nt = K / BK;
    unsigned voffA[2], voffB[2];
#pragma unroll
    for (int i = 0; i < 2; ++i) { int R, C; stage_rc(tid * 16 + i * 8192, R, C); const int Rb = Epi::PERM ? ((R & ~31) + perm32(R & 31)) : R;
        voffA[i] = (unsigned)(R * K + C) * 2u; voffB[i] = (unsigned)(Rb * K + C) * 2u; }
    const size_t kstep = (size_t)(BK * 2);
    const size_t hstep = (size_t)HALF * K * 2;
    const size_t tstep = 2 * hstep;
    const unsigned ldsw = (unsigned)wid * 1024u;
    const int aoff = lds_byte(wr * 64 + fr, fq * 8), boff = lds_byte(wc * 32 + fr, fq * 8);
#define PG8_SA(b, h) (((b) * 2 + (h)) * HTB)
#define PG8_SB(b, h) ((4 + (b) * 2 + (h)) * HTB)
#define PG8_STAGE(bufoff, gbase, voff) do { _Pragma("unroll") for (int _i = 0; _i < 2; ++_i) \
        __builtin_amdgcn_global_load_lds((const unsigned*)((const char*)(gbase) + (voff)[_i]), (PG8_LAS unsigned*)(lds + (bufoff) + ldsw + _i * 8192), 16, 0, 0); } while (0)
#define PG8_LDA(dst, b, h) do { _Pragma("unroll") for (int m = 0; m < 4; ++m) _Pragma("unroll") for (int k = 0; k < 2; ++k) dst[m][k] = *(const PG8_LAS bf16x8*)(lds + PG8_SA(b, h) + aoff + m * 2048 + k * 1024); } while (0)
#define PG8_LDB(dst, b, h) do { _Pragma("unroll") for (int n = 0; n < 2; ++n) _Pragma("unroll") for (int k = 0; k < 2; ++k) dst[n][k] = *(const PG8_LAS bf16x8*)(lds + PG8_SB(b, h) + boff + n * 2048 + k * 1024); } while (0)
#define PG8_MMA(ai, bj, At, Bt) do { __builtin_amdgcn_s_setprio(1); _Pragma("unroll") for (int m = 0; m < 4; ++m) _Pragma("unroll") for (int n = 0; n < 2; ++n) _Pragma("unroll") for (int k = 0; k < 2; ++k) \
        acc[ai][bj][m][n] = __builtin_amdgcn_mfma_f32_16x16x32_bf16(Bt[n][k], At[m][k], acc[ai][bj][m][n], 0, 0, 0); __builtin_amdgcn_s_setprio(0); } while (0)
#define PG8_WAIT_V(n) asm volatile("s_waitcnt vmcnt(" #n ")" ::: "memory")
#define PG8_WAIT_L(n) asm volatile("s_waitcnt lgkmcnt(" #n ")" ::: "memory")
#define PG8_BAR __builtin_amdgcn_s_barrier()
#define PG8_SCHED __builtin_amdgcn_sched_barrier(0)
    Unit cur, nxt; int ui = 0;
    if (!S.next(0, cur)) return;
    f32x4 acc[2][2][4][2];
#pragma unroll
    for (int a = 0; a < 2; ++a)
#pragma unroll
        for (int b = 0; b < 2; ++b)
#pragma unroll
            for (int m = 0; m < 4; ++m)
#pragma unroll
                for (int n = 0; n < 2; ++n) acc[a][b][m][n] = (f32x4){0.f, 0.f, 0.f, 0.f};
    bf16x8 At[4][2], B0[2][2], B1[2][2];
    const char* cA = (const char*)g.A + (size_t)cur.z * g.sAz * 2 + (size_t)cur.pm * tstep; const char* cB = (const char*)g.Bt + (size_t)cur.z * g.sBz * 2 + (size_t)cur.pn * tstep;
    S.a_ready(cur);
    if constexpr (SP2) {
        PG8_STAGE(PG8_SB(0, 0), cB, voffB); PG8_STAGE(PG8_SB(0, 1), cB + hstep, voffB); PG8_STAGE(PG8_SA(0, 0), cA, voffA); PG8_STAGE(PG8_SA(0, 1), cA + hstep, voffA);
        if (wr == 1) PG8_BAR;
        PG8_WAIT_V(2); PG8_BAR;
        PG8_STAGE(PG8_SB(1, 0), cB + kstep, voffB); PG8_STAGE(PG8_SA(1, 0), cA + kstep, voffA); PG8_STAGE(PG8_SB(1, 1), cB + hstep + kstep, voffB);
        PG8_WAIT_V(6); PG8_BAR;
    } else {
        PG8_STAGE(PG8_SB(0, 0), cB, voffB); PG8_STAGE(PG8_SA(0, 0), cA, voffA); PG8_STAGE(PG8_SB(0, 1), cB + hstep, voffB); PG8_STAGE(PG8_SA(0, 1), cA + hstep, voffA);
        if (wr == 1) PG8_BAR;
        PG8_WAIT_V(4); PG8_BAR;
        PG8_STAGE(PG8_SB(1, 0), cB + kstep, voffB); PG8_STAGE(PG8_SA(1, 0), cA + kstep, voffA); PG8_STAGE(PG8_SB(1, 1), cB + hstep + kstep, voffB);
        PG8_WAIT_V(6); PG8_BAR;
    }
    for (;;) {
        const bool has_next = S.next(ui + 1, nxt);
        const char* nA = has_next ? (const char*)g.A + (size_t)nxt.z * g.sAz * 2 + (size_t)nxt.pm * tstep : cA; const char* nB = has_next ? (const char*)g.Bt + (size_t)nxt.z * g.sBz * 2 + (size_t)nxt.pn * tstep : cB;
        for (int t = 0; t < nt; t += 2) {
            const bool last = (t == nt - 2);
            const char* a1 = cA + (size_t)(t + 1) * kstep;
            const char* a2 = last ? nA : cA + (size_t)(t + 2) * kstep; const char* b2 = last ? nB : cB + (size_t)(t + 2) * kstep;
            const char* a3 = a2 + kstep; const char* b3 = b2 + kstep;
            if (last && has_next) S.a_ready(nxt);
            if constexpr (SP2) {
            PG8_LDB(B0, 0, 0); PG8_LDB(B1, 0, 1); PG8_SCHED; PG8_LDA(At, 0, 0); PG8_STAGE(PG8_SA(1, 1), a1 + hstep, voffA);
            PG8_WAIT_V(8); PG8_WAIT_L(0); PG8_BAR; PG8_MMA(0, 0, At, B0); PG8_MMA(0, 1, At, B1); PG8_BAR; PG8_SCHED;
            PG8_LDA(At, 0, 1); PG8_STAGE(PG8_SB(0, 0), b2, voffB); PG8_STAGE(PG8_SB(0, 1), b2 + hstep, voffB); PG8_STAGE(PG8_SA(0, 0), a2, voffA);
            PG8_WAIT_V(8); PG8_WAIT_L(0); PG8_BAR; PG8_MMA(1, 0, At, B0); PG8_MMA(1, 1, At, B1); PG8_BAR; PG8_SCHED;
            PG8_LDB(B0, 1, 0); PG8_LDB(B1, 1, 1); PG8_SCHED; PG8_LDA(At, 1, 0); PG8_STAGE(PG8_SA(0, 1), a2 + hstep, voffA);
            PG8_WAIT_V(8); PG8_WAIT_L(0); PG8_BAR; PG8_MMA(0, 0, At, B0); PG8_MMA(0, 1, At, B1); PG8_BAR; PG8_SCHED;
            PG8_LDA(At, 1, 1); PG8_STAGE(PG8_SB(1, 0), b3, voffB); PG8_STAGE(PG8_SB(1, 1), b3 + hstep, voffB); PG8_STAGE(PG8_SA(1, 0), a3, voffA);
            PG8_WAIT_V(8); PG8_WAIT_L(0); PG8_BAR; PG8_MMA(1, 0, At, B0); PG8_MMA(1, 1, At, B1); PG8_BAR; PG8_SCHED;
            } else {
            PG8_LDB(B0, 0, 0); PG8_SCHED; PG8_LDA(At, 0, 0); PG8_STAGE(PG8_SA(1, 1), a1 + hstep, voffA);
            PG8_WAIT_L(8); PG8_BAR; PG8_WAIT_L(0); PG8_MMA(0, 0, At, B0); PG8_BAR; PG8_SCHED;
            PG8_LDB(B1, 0, 1); PG8_STAGE(PG8_SB(0, 0), b2, voffB);
            PG8_BAR; PG8_WAIT_L(0); PG8_MMA(0, 1, At, B1); PG8_BAR;
            PG8_LDA(At, 0, 1); PG8_STAGE(PG8_SA(0, 0), a2, voffA);
            PG8_BAR; PG8_WAIT_L(0); PG8_MMA(1, 0, At, B0); PG8_BAR; PG8_SCHED;
            PG8_STAGE(PG8_SB(0, 1), b2 + hstep, voffB);
            PG8_WAIT_V(6); PG8_BAR; PG8_MMA(1, 1, At, B1); PG8_BAR;
            PG8_LDB(B0, 1, 0); PG8_SCHED; PG8_LDA(At, 1, 0); PG8_STAGE(PG8_SA(0, 1), a2 + hstep, voffA);
            PG8_WAIT_L(8); PG8_BAR; PG8_WAIT_L(0); PG8_MMA(0, 0, At, B0); PG8_BAR; PG8_SCHED;
            PG8_LDB(B1, 1, 1); PG8_STAGE(PG8_SB(1, 0), b3, voffB);
            PG8_BAR; PG8_WAIT_L(0); PG8_MMA(0, 1, At, B1); PG8_BAR;
            PG8_LDA(At, 1, 1); PG8_STAGE(PG8_SA(1, 0), a3, voffA);
            PG8_BAR; PG8_WAIT_L(0); PG8_MMA(1, 0, At, B0); PG8_BAR; PG8_SCHED;
            PG8_STAGE(PG8_SB(1, 1), b3 + hstep, voffB);
            PG8_WAIT_V(6); PG8_BAR; PG8_MMA(1, 1, At, B1); PG8_BAR;
            }
        }
        if constexpr (ALIGN_EPI) { if (wr == 0) PG8_BAR; }
        if constexpr (!Epi::AFTER_DRAIN) { E(acc, cur, wr, wc, fr, fq); S.done(cur); }
        if (!has_next) break;
#pragma unroll
        for (int a = 0; a < 2; ++a)
#pragma unroll
            for (int b = 0; b < 2; ++b)
#pragma unroll
                for (int m = 0; m < 4; ++m)
#pragma unroll
                    for (int n = 0; n < 2; ++n) acc[a][b][m][n] = (f32x4){0.f, 0.f, 0.f, 0.f};
        cur = nxt; cA = nA; cB = nB; ++ui;
        if constexpr (ALIGN_EPI) { if (wr == 1) PG8_BAR; }
    }
    PG8_WAIT_V(0);
    if constexpr (!ALIGN_EPI) { if (wr == 0) PG8_BAR; }
    PG8_BAR;
    if constexpr (Epi::AFTER_DRAIN) { E.fused(acc, cur, wr, wc, fr, fq, lds, wid, lane); S.done(cur); }
#undef PG8_SA
#undef PG8_SB
#undef PG8_STAGE
#undef PG8_LDA
#undef PG8_LDB
#undef PG8_MMA
#undef PG8_WAIT_V
#undef PG8_WAIT_L
#undef PG8_BAR
#undef PG8_SCHED
}
}

typedef unsigned short bf16;
typedef unsigned v4u __attribute__((ext_vector_type(4)));
typedef unsigned v2u __attribute__((ext_vector_type(2)));
typedef float f32x4 __attribute__((ext_vector_type(4)));
typedef float f32x16 __attribute__((ext_vector_type(16)));
typedef short bf16x8 __attribute__((ext_vector_type(8)));
#define LDS_WAIT() asm volatile("s_waitcnt lgkmcnt(0)" ::: "memory")
#define VM_WAIT() asm volatile("s_waitcnt vmcnt(0)" ::: "memory")
__device__ __forceinline__ unsigned pk2(float lo, float hi) { return pg8::cvt_pk_bf16(lo, hi); }
__device__ __forceinline__ f32x4 ld4(const float* p) { return *(const f32x4*)p; }
__device__ __forceinline__ f32x4 unb4(const v2u u) { return (f32x4){__uint_as_float(u.x << 16), __uint_as_float(u.x & 0xffff0000u), __uint_as_float(u.y << 16), __uint_as_float(u.y & 0xffff0000u)}; }
__device__ __forceinline__ f32x4 ldb4(const unsigned short* p) { const v2u u = *(const v2u*)p; return (f32x4){__uint_as_float(u.x << 16), __uint_as_float(u.x & 0xffff0000u), __uint_as_float(u.y << 16), __uint_as_float(u.y & 0xffff0000u)}; }
__device__ __forceinline__ float sum4(const f32x4 v) { return (v[0] + v[1]) + (v[2] + v[3]); }
__device__ __forceinline__ float sq4(const f32x4 v) { return (v[0] * v[0] + v[1] * v[1]) + (v[2] * v[2] + v[3] * v[3]); }
__device__ __forceinline__ float wave_sum(float v) {
#pragma unroll
    for (int o = 1; o < 64; o <<= 1) v += __shfl_xor(v, o);
    return v;
}
__device__ __forceinline__ float sum16(float v) { v += __shfl_xor(v, 1); v += __shfl_xor(v, 2); v += __shfl_xor(v, 4); v += __shfl_xor(v, 8); return v; }
__device__ __forceinline__ float sum8_dpp(float x) {
    x += __builtin_bit_cast(float, __builtin_amdgcn_update_dpp(0, __builtin_bit_cast(int, x), 0xB1, 0xF, 0xF, true));
    x += __builtin_bit_cast(float, __builtin_amdgcn_update_dpp(0, __builtin_bit_cast(int, x), 0x4E, 0xF, 0xF, true));
    x += __builtin_bit_cast(float, __builtin_amdgcn_update_dpp(0, __builtin_bit_cast(int, x), 0x141, 0xF, 0xF, true));
    return x;
}
__device__ __forceinline__ float sigmoid_p(float x) { return 1.0f / (1.0f + expf(-x)); }
__device__ __forceinline__ bf16x8 pack8(const f32x4 a, const f32x4 b) { v4u w; w.x = pk2(a[0], a[1]); w.y = pk2(a[2], a[3]); w.z = pk2(b[0], b[1]); w.w = pk2(b[2], b[3]); return __builtin_bit_cast(bf16x8, w); }

constexpr size_t MiB = 1u << 20;
constexpr size_t WS_CTL = 0, CTL_ZERO_BYTES = 1 * MiB;
constexpr size_t WS_SSP = 1 * MiB;
constexpr size_t WS_BIAS = 9 * MiB;
constexpr size_t WS_WIN = 16 * MiB;
constexpr size_t WS_WOUT = WS_WIN + 768 * MiB;
constexpr size_t WS_WRKV = WS_WOUT + 384 * MiB;
constexpr size_t WS_WO = WS_WRKV + 192 * MiB;
constexpr size_t WS_WGLU = WS_WO + 64 * MiB;
constexpr size_t WS_WL1 = WS_WGLU + 128 * MiB;
constexpr size_t WS_WL2 = WS_WL1 + 16 * MiB;
constexpr size_t WS_XB = WS_WL2 + 16 * MiB;
constexpr size_t WS_ACT = WS_XB + 128 * MiB;
constexpr size_t WS_XR = WS_ACT + 192 * MiB;
constexpr size_t WS_HB = WS_XR + 384 * MiB;
constexpr size_t WS_Z = WS_HB + 128 * MiB;
constexpr size_t WS_MID = WS_Z + 64 * MiB;
constexpr size_t WS_R = WS_MID + 32 * MiB;
constexpr size_t WS_K = WS_R + 256 * MiB;
constexpr size_t WS_V0 = WS_K + 256 * MiB;
constexpr size_t WS_V1 = WS_V0 + 256 * MiB;
constexpr size_t WS_LO = WS_V1 + 256 * MiB;
constexpr size_t WS_YG = WS_LO + 1024 * MiB;
constexpr size_t WS_IMG = WS_YG + 128 * MiB;
constexpr size_t WS_END = WS_IMG + 680 * MiB;
constexpr int CW_BAR = 4096;

constexpr int RING_BYTES = 131072;
constexpr int LDSCTL_OFF = RING_BYTES;
constexpr int RSL_OFF = RING_BYTES + 1024;
constexpr int LDS_BYTES = 147456;

#define XB_TMO      128
#define XB_XCNT(j)  (256  + 64 * (j))
#define XB_XSUB(j)  (1280 + 64 * (j))
#define XB_XGEN(j)  (2304 + 64 * (j))
#define XB_TOP      3328
#define XB_TOPGEN   3392
#define XCD_BAR_WORDS 3456
#define XB_SPIN_CAP (1u << 18)

__device__ __forceinline__ unsigned xb_ld(unsigned* p)              { return __hip_atomic_load(p, __ATOMIC_RELAXED, __HIP_MEMORY_SCOPE_AGENT); }
__device__ __forceinline__ unsigned xb_add(unsigned* p, unsigned v) { return __hip_atomic_fetch_add(p, v, __ATOMIC_RELAXED, __HIP_MEMORY_SCOPE_AGENT); }
__device__ __forceinline__ unsigned xb_xcc_id() { return (unsigned)__builtin_amdgcn_s_getreg((3 << 11) | 20) & 0xFu; }
#define XB_SPIN(cond, bar) do { unsigned _sp = 0; while (cond) { __builtin_amdgcn_s_sleep(1); \
    if ((++_sp & 255u) == 0u) { if (xb_ld(&(bar)[XB_TMO])) break; if (_sp > XB_SPIN_CAP) { atomicAdd(&(bar)[XB_TMO], 1u); break; } } } } while (0)

struct XcdBarrier {
    unsigned* bar; unsigned x;
    volatile LAS unsigned* st;
};

__device__ __forceinline__ XcdBarrier xcd_barrier_post(unsigned* bar, volatile LAS unsigned* st) {
    XcdBarrier b; b.bar = bar; b.x = xb_xcc_id(); b.st = st;
    if (threadIdx.x == 0) (void)xb_add(&bar[XB_XCNT(b.x)], 1u);
    return b;
}
__device__ __forceinline__ void xcd_barrier_complete(unsigned* bar, unsigned x, unsigned& nloc, unsigned& nx) {
    const unsigned G = gridDim.x * gridDim.y * gridDim.z;
    unsigned sum, cnt, mine, sp = 0u;
    for (;;) {
        sum = 0u; cnt = 0u; mine = 0u;
#pragma unroll
        for (unsigned j = 0; j < 16; ++j) { const unsigned c = xb_ld(&bar[XB_XCNT(j)]); sum += c; cnt += (c > 0u) ? 1u : 0u; mine = (j == x) ? c : mine; }
        if (sum == G) break;
        __builtin_amdgcn_s_sleep(1);
        if ((++sp & 255u) == 0u) { if (xb_ld(&bar[XB_TMO])) break; if (sp > XB_SPIN_CAP) { atomicAdd(&bar[XB_TMO], 1u); break; } }
    }
    nloc = mine > 0u ? mine : 1u; nx = cnt > 0u ? cnt : 1u;
}

__device__ __forceinline__ void xcd_barrier(const XcdBarrier& b) {
    asm volatile("s_waitcnt vmcnt(0)" ::: "memory");
    __syncthreads();
    if (threadIdx.x == 0) {
        unsigned* bar = b.bar;
        __builtin_amdgcn_s_waitcnt(0);
        unsigned nloc = b.st[0], nx = b.st[1];
        if (nloc == 0u) { xcd_barrier_complete(bar, b.x, nloc, nx); b.st[0] = nloc; b.st[1] = nx; }
        const unsigned old = xb_add(&bar[XB_XSUB(b.x)], 1u);
        const unsigned gen = old / nloc;
        if (old + 1u == (gen + 1u) * nloc) {
            __builtin_amdgcn_fence(__ATOMIC_RELEASE, "agent");
            asm volatile("s_waitcnt vmcnt(0)" ::: "memory");
            const unsigned og = xb_add(&bar[XB_TOP], 1u);
            const unsigned tg = og / nx;
            if (og + 1u == (tg + 1u) * nx) xb_add(&bar[XB_TOPGEN], 1u);
            else XB_SPIN(xb_ld(&bar[XB_TOPGEN]) == tg, bar);
            __builtin_amdgcn_fence(__ATOMIC_ACQUIRE, "agent");
            xb_add(&bar[XB_XGEN(b.x)], 1u);
            asm volatile("s_waitcnt vmcnt(0)" ::: "memory");
        } else {
            XB_SPIN(xb_ld(&bar[XB_XGEN(b.x)]) == gen, bar);
            __builtin_amdgcn_fence(__ATOMIC_ACQUIRE, "agent");
            asm volatile("s_waitcnt vmcnt(0)" ::: "memory");
        }
    }
    __syncthreads();
}

struct Args { const float* in[34]; float* out; unsigned char* ws; int ph_lo, ph_hi; };
struct Frame { LAS unsigned char* lds; int tid, lane, wave, G, gw, NGW; };
enum { I_X = 0, I_FFN_NORM, I_FFN_WIN, I_FFN_WOUT, I_MIX_NORM, I_MU, I_WRKV, I_WO, I_W0, I_WL1, I_WL2, I_A0, I_AL1, I_AL2, I_V0, I_VL1, I_VL2, I_GL1, I_GL2, I_KK, I_KA, I_RK, I_LNW, I_LNB,
       I_LRE, I_LIM, I_LSTEP, I_BRE, I_BIM, I_CRE, I_CIM, I_S5D, I_WGLU, I_FNORM };

struct TrDesc { const float* src; bf16* dst; const float* scale; int ldw, K; };
__device__ __forceinline__ TrDesc tr_decode(const Args& a, int it) {
    unsigned char* ws = a.ws;
    constexpr int IT_IN = (D / 64) * (2 * FF / 32), IT_OUT = (FF / 64) * (D / 32), IT_SQ = (D / 64) * (D / 32), IT_GLU = (D / 64) * (2 * D / 32);
    constexpr int N_IN = 8 * IT_IN, N_OUT = 8 * IT_OUT, N_RKV = 6 * IT_SQ, N_O = 2 * IT_SQ;
    const int cat = it < N_IN ? 0 : (it < N_IN + N_OUT ? 1 : (it < N_IN + N_OUT + N_RKV ? 2 : (it < N_IN + N_OUT + N_RKV + N_O ? 3 : 4)));
    const int r0 = it - (cat == 0 ? 0 : (cat == 1 ? N_IN : (cat == 2 ? N_IN + N_OUT : (cat == 3 ? N_IN + N_OUT + N_RKV : N_IN + N_OUT + N_RKV + N_O))));
    const int per = cat == 0 ? IT_IN : (cat == 1 ? IT_OUT : (cat == 4 ? IT_GLU : IT_SQ));
    const int mi = r0 / per, r = r0 - mi * per;
    const int ldw = cat == 0 ? 2 * FF : (cat == 4 ? 2 * D : D), K = cat == 1 ? FF : D, nblk = ldw / 32, kb = r / nblk, nb = r - kb * nblk, n0 = 32 * nb;
    const int split = cat == 0 ? FF : D, hs = n0 >= split ? 1 : 0, jj = n0 - hs * split;
    const int drow0 = (cat == 0 || cat == 4) ? (jj >> 7) * 256 + hs * 128 + (jj & 127) : n0;
    const float* sb = cat == 0 ? a.in[I_FFN_WIN] : (cat == 1 ? a.in[I_FFN_WOUT] : (cat == 2 ? a.in[I_WRKV] : (cat == 3 ? a.in[I_WO] : a.in[I_WGLU])));
    const size_t woff = cat == 0 ? WS_WIN : (cat == 1 ? WS_WOUT : (cat == 2 ? WS_WRKV : (cat == 3 ? WS_WO : WS_WGLU)));
    const size_t msz = (size_t)ldw * K;
    TrDesc d;
    d.src = sb + (size_t)mi * msz + (size_t)(64 * kb) * ldw + n0; d.ldw = ldw; d.K = K;
    d.dst = (bf16*)(ws + woff) + (size_t)mi * msz + (size_t)drow0 * K + 64 * kb;
    d.scale = cat == 0 ? a.in[I_FFN_NORM] + (size_t)mi * D + 64 * kb : nullptr;
    return d;
}
__device__ __forceinline__ void tr_load(const TrDesc& d, int lane, float (&v)[32]) {
    const float* p = d.src + (size_t)(lane >> 5) * d.ldw + (lane & 31);
#pragma unroll
    for (int i = 0; i < 32; ++i) v[i] = __builtin_nontemporal_load(p + (size_t)(2 * i) * d.ldw);
}
__device__ __forceinline__ void tr_store(const TrDesc& d, int lane, LAS float* scr, const float (&v)[32]) {
#pragma unroll
    for (int i = 0; i < 32; ++i) scr[(2 * i + (lane >> 5)) * 33 + (lane & 31)] = v[i];
    LDS_WAIT(); asm volatile("" ::: "memory");
    const int c = lane & 7;
    f32x4 s0 = (f32x4){1.f, 1.f, 1.f, 1.f}, s1 = s0;
    if (d.scale) { s0 = ld4(d.scale + 8 * c); s1 = ld4(d.scale + 8 * c + 4); }
#pragma unroll
    for (int j = 0; j < 4; ++j) { const int n = (lane >> 3) + 8 * j; const LAS float* s = scr + (8 * c) * 33 + n;
        v4u o; o.x = pk2(s[0 * 33] * s0[0], s[1 * 33] * s0[1]); o.y = pk2(s[2 * 33] * s0[2], s[3 * 33] * s0[3]); o.z = pk2(s[4 * 33] * s1[0], s[5 * 33] * s1[1]); o.w = pk2(s[6 * 33] * s1[2], s[7 * 33] * s1[3]);
        __builtin_nontemporal_store(o, (v4u*)(d.dst + (size_t)n * d.K + 8 * c)); }
    LDS_WAIT(); asm volatile("" ::: "memory");
}
__device__ __forceinline__ int conv_set_count(int set) {
    constexpr int IT_IN = (D / 64) * (2 * FF / 32), IT_OUT = (FF / 64) * (D / 32), IT_SQ = (D / 64) * (D / 32), IT_GLU = (D / 64) * (2 * D / 32);
    return (set == 0 || set == 2) ? 2 * IT_IN + 2 * IT_OUT + 4 * IT_SQ : 2 * IT_IN + 2 * IT_OUT + IT_GLU;
}
__device__ __forceinline__ int conv_set_item(int set, int idx) {
    constexpr int IT_IN = (D / 64) * (2 * FF / 32), IT_OUT = (FF / 64) * (D / 32), IT_SQ = (D / 64) * (D / 32), IT_GLU = (D / 64) * (2 * D / 32);
    constexpr int B_IN = 0, B_OUT = 8 * IT_IN, B_RKV = B_OUT + 8 * IT_OUT, B_O = B_RKV + 6 * IT_SQ, B_GLU = B_O + 2 * IT_SQ;
    const int in_lo = 2 * set;
    const bool rw = (set & 1) == 0;
    int r = idx;
    if (r < 2 * IT_IN) return B_IN + in_lo * IT_IN + r;
    r -= 2 * IT_IN;
    if (r < 2 * IT_OUT) return B_OUT + in_lo * IT_OUT + r;
    r -= 2 * IT_OUT;
    if (rw) { if (r < 3 * IT_SQ) return B_RKV + 3 * (set >> 1) * IT_SQ + r; r -= 3 * IT_SQ; return B_O + (set >> 1) * IT_SQ + r; }
    return B_GLU + (set >> 1) * IT_GLU + r;
}
__device__ __forceinline__ void convert_set(const Args& a, int lane, LAS float* scr, int set, int wave_id, int nwaves) {
    const int n = conv_set_count(set);
    int it = wave_id; TrDesc d, dn; float v[32], vn[32];
    bool has = it < n;
    if (has) { d = tr_decode(a, conv_set_item(set, it)); tr_load(d, lane, v); }
    while (has) {
        const int nx = it + nwaves; const bool hn = nx < n;
        if (hn) { dn = tr_decode(a, conv_set_item(set, nx)); tr_load(dn, lane, vn); }
        tr_store(d, lane, scr, v);
        d = dn; it = nx; has = hn;
#pragma unroll
        for (int i = 0; i < 32; ++i) v[i] = vn[i];
    }
}
__device__ __forceinline__ void p0_prologue(const Args& a, Frame& F) {
    unsigned char* ws = a.ws;
    convert_set(a, F.lane, (LAS float*)(F.lds + F.wave * 16384), 0, F.gw, F.NGW);
    if (F.G <= BATCH * NH) { convert_set(a, F.lane, (LAS float*)(F.lds + F.wave * 16384), 1, F.gw, F.NGW); convert_set(a, F.lane, (LAS float*)(F.lds + F.wave * 16384), 2, F.gw, F.NGW); convert_set(a, F.lane, (LAS float*)(F.lds + F.wave * 16384), 3, F.gw, F.NGW); }
    const int gt = F.gw * 64 + F.lane, NGT = F.NGW * 64;
    for (int idx = gt; idx < 2 * 1024 * D; idx += NGT) {
        const int j = idx / (1024 * D), rem = idx % (1024 * D), n = rem / D, k = rem % D, half = n >> 9, nn = n & 511;
        float v = 0.f; const float* src = nullptr; int rank = 0, off = 0, murow = 0;
        if (nn < 128) { src = a.in[I_WL1] + (size_t)j * D * WL; rank = WL; off = 0; murow = 3; }
        else if (nn < 256) { src = a.in[I_AL1] + (size_t)j * D * AL; rank = AL; off = 128; murow = 4; }
        else if (nn < 352) { src = a.in[I_GL1] + (size_t)j * D * GL; rank = GL; off = 256; murow = 5; }
        else if (nn < 448 && j >= 1) { src = a.in[I_VL1] + (size_t)(j - 1) * D * VL; rank = VL; off = 352; murow = 2; }
        if (src) { const float mu = a.in[I_MU][(size_t)(j * 6 + murow) * D + k]; v = src[(size_t)k * rank + (nn - off)] * (half ? mu : 1.0f - mu); }
        ((bf16*)(ws + WS_WL1))[idx] = (bf16)(pk2(v, 0.f) & 0xffffu);
    }
    for (int idx = gt; idx < 2 * 4 * 128 * D; idx += NGT) {
        const int j = idx / (4 * 128 * D), rem = idx % (4 * 128 * D), c = rem / (128 * D), rem2 = rem % (128 * D), n = rem2 / 128, k = rem2 % 128;
        float v = 0.f;
        if (c == 0) { if (k < WL) v = a.in[I_WL2][((size_t)j * WL + k) * D + n]; }
        else if (c == 1) { if (k < AL) v = a.in[I_AL2][((size_t)j * AL + k) * D + n]; }
        else if (c == 2) { if (k < GL) v = a.in[I_GL2][((size_t)j * GL + k) * D + n]; }
        else { if (k < VL && j >= 1) v = a.in[I_VL2][((size_t)(j - 1) * VL + k) * D + n]; }
        ((bf16*)(ws + WS_WL2))[((size_t)(j * 4 + c) * D + n) * 128 + k] = (bf16)(pk2(v, 0.f) & 0xffffu);
    }
    for (int idx = gt; idx < 2 * 4 * D; idx += NGT) {
        const int j = idx / (4 * D), c = (idx / D) & 3, n = idx % D; float v = 0.f;
        if (c == 0) v = a.in[I_W0][j * D + n]; else if (c == 1) v = a.in[I_A0][j * D + n]; else if (c == 3 && j >= 1) v = a.in[I_V0][(j - 1) * D + n];
        ((float*)(ws + WS_BIAS))[idx] = v;
    }
    for (int row = F.gw; row < M; row += F.NGW) {
        const float* xr = a.in[I_X] + (size_t)row * D + 4 * F.lane; bf16* xb = (bf16*)(ws + WS_XB) + (size_t)row * D + 4 * F.lane; float ss = 0.f;
#pragma unroll 4
        for (int q = 0; q < 16; ++q) { const f32x4 v = __builtin_nontemporal_load((const f32x4*)(xr + 256 * q)); ss += sq4(v); v2u w; w.x = pk2(v[0], v[1]); w.y = pk2(v[2], v[3]); *(v2u*)(xb + 256 * q) = w; }
        ((float*)(ws + WS_SSP))[(size_t)row * SSPW + F.lane] = ss;
    }
}

__device__ __forceinline__ void rwkv_prep(const Args& a, Frame& F, int j, int li) {
    const bf16* X = (const bf16*)(a.ws + WS_XB); const float* ssp = (const float*)(a.ws + WS_SSP); const float* gm = a.in[I_MIX_NORM] + (size_t)li * D; const float* mu = a.in[I_MU] + (size_t)j * 6 * D;
    bf16* XR = (bf16*)(a.ws + WS_XR); bf16* XK = XR + (size_t)M * D; bf16* XV = XK + (size_t)M * D; bf16* HB = (bf16*)(a.ws + WS_HB);
    for (int run = F.gw; run < M / 8; run += F.NGW) {
        const int row0 = run * 8; const bool first = (row0 % T) == 0;
        float rs[9];
#pragma unroll
        for (int r = 0; r < 9; ++r) { const int row = row0 - 1 + r; float s = (r == 0 && first) ? 1.f : ssp[(size_t)row * SSPW + F.lane]; s = wave_sum(s); rs[r] = __builtin_amdgcn_rsqf(s * (1.0f / D) + RMS_EPS); }
        for (int q = 0; q < 16; ++q) {
            const int col = 256 * q + 4 * F.lane;
            const f32x4 g4 = ld4(gm + col), mr = ld4(mu + col), mk = ld4(mu + D + col), mv = ld4(mu + 2 * D + col);
            f32x4 hp = (f32x4){0.f, 0.f, 0.f, 0.f};
            if (!first) hp = ldb4(X + (size_t)(row0 - 1) * D + col) * rs[0] * g4;
#pragma unroll
            for (int r = 0; r < 8; ++r) { const size_t o = (size_t)(row0 + r) * D + col;
                const f32x4 h = ldb4(X + o) * rs[r + 1] * g4, dx = hp - h, xr = h + dx * mr, xk = h + dx * mk, xv = h + dx * mv;
                v2u w; w.x = pk2(xr[0], xr[1]); w.y = pk2(xr[2], xr[3]); *(v2u*)(XR + o) = w;
                w.x = pk2(xk[0], xk[1]); w.y = pk2(xk[2], xk[3]); *(v2u*)(XK + o) = w;
                w.x = pk2(xv[0], xv[1]); w.y = pk2(xv[2], xv[3]); *(v2u*)(XV + o) = w;
                w.x = pk2(h[0], h[1]); w.y = pk2(h[2], h[3]); *(v2u*)(HB + o) = w;
                hp = h; }
        }
    }
}
__device__ __forceinline__ void rwkv_mid(const Args& a, Frame& F, int j) {
    const float* Z = (const float*)(a.ws + WS_Z); bf16* MID = (bf16*)(a.ws + WS_MID);
    const int gt = F.gw * 64 + F.lane, NGT = F.NGW * 64, nz = j ? 4 : 3;
    for (int idx = gt; idx < nz * M * 16; idx += NGT) {
        const int z = idx / (M * 16), rem = idx % (M * 16), t = rem >> 4, k8 = (rem & 15) * 8;
        const int rank = z < 2 ? 128 : 96, off = z == 0 ? 0 : (z == 1 ? 128 : (z == 2 ? 256 : 352));
        v4u w = (v4u){0u, 0u, 0u, 0u};
        if (k8 < rank) {
            const float* za = Z + (size_t)t * 1024 + off + k8; f32x4 v0 = ld4(za), v1 = ld4(za + 4);
            if ((t % T) != 0) { const float* zb = Z + (size_t)(t - 1) * 1024 + 512 + off + k8; v0 = v0 + ld4(zb); v1 = v1 + ld4(zb + 4); }
            if (z == 0) {
#pragma unroll
                for (int e = 0; e < 4; ++e) { v0[e] = tanhf(v0[e]); v1[e] = tanhf(v1[e]); } }
            else if (z == 2) {
#pragma unroll
                for (int e = 0; e < 4; ++e) { v0[e] = sigmoid_p(v0[e]); v1[e] = sigmoid_p(v1[e]); } }
            w.x = pk2(v0[0], v0[1]); w.y = pk2(v0[2], v0[3]); w.z = pk2(v1[0], v1[1]); w.w = pk2(v1[2], v1[3]);
        }
        *(v4u*)(MID + ((size_t)z * M + t) * 128 + k8) = w;
    }
}
__device__ __forceinline__ void rwkv_rec(const Args& a, Frame& F, int j) {
    for (int item = blockIdx.x; item < BATCH * NH; item += F.G) {
    const int b = item / NH, h = item % NH, tid = F.tid;
    LAS float* L = (LAS float*)F.lds;
    LAS float *sKK = L, *sW = L + 2048, *sB = L + 4096, *sKP = L + 6144, *sR = L + 8192, *sV = L + 10240, *sY = L + 12288, *sBon = L + 14336;
    const int tt = tid >> 4, cq = tid & 15, col = h * 64 + 4 * cq;
    const f32x4 kk4 = ld4(a.in[I_KK] + (size_t)j * D + col), ka4 = ld4(a.in[I_KA] + (size_t)j * D + col), rk4 = ld4(a.in[I_RK] + (size_t)j * D + col),
                lnw4 = ld4(a.in[I_LNW] + (size_t)j * D + col), lnb4 = ld4(a.in[I_LNB] + (size_t)j * D + col);
    const float* Rp = (const float*)(a.ws + WS_R); const float* Kp = (const float*)(a.ws + WS_K); const float* Vp = (const float*)(a.ws + (j ? WS_V1 : WS_V0)); const float* VF = (const float*)(a.ws + WS_V0);
    const float* WP = (const float*)(a.ws + WS_LO); const float* AP = WP + (size_t)M * D; const float* GP = AP + (size_t)M * D; const float* VG = GP + (size_t)M * D;
    bf16* YG = (bf16*)(a.ws + WS_YG);
    const int vl = F.lane >> 3, kq = F.lane & 7, vrow = 8 * F.wave + vl;
    float S[8];
#pragma unroll
    for (int e = 0; e < 8; ++e) S[e] = 0.f;
    size_t base = ((size_t)(b * T + tt)) * D + col;
    f32x4 r4 = ld4(Rp + base), k4 = ld4(Kp + base), v4 = ld4(Vp + base), wp4 = ld4(WP + base), ap4 = ld4(AP + base), g4 = ld4(GP + base);
    f32x4 vg4 = (f32x4){0.f, 0.f, 0.f, 0.f}, vf4 = vg4;
    if (j) { vg4 = ld4(VG + base); vf4 = ld4(VF + base); }
    for (int c = 0; c < T / 32; ++c) {
        f32x4 aa, ww, vv, kk, kp, bb; float ss = 0.f, bon = 0.f;
#pragma unroll
        for (int e = 0; e < 4; ++e) {
            aa[e] = sigmoid_p(ap4[e]);
            const float zz = -wp4[e], sp = fmaxf(zz, 0.f) + log1pf(expf(-fabsf(zz)));
            ww[e] = expf(-expf(-sp - 0.5f));
            vv[e] = j ? v4[e] + (vf4[e] - v4[e]) * sigmoid_p(vg4[e]) : v4[e];
            kk[e] = k4[e] * kk4[e]; kp[e] = k4[e] * (1.0f + (aa[e] - 1.0f) * ka4[e]);
            ss += kk[e] * kk[e]; bon += r4[e] * kp[e] * rk4[e];
        }
        ss = sum16(ss); bon = sum16(bon);
        const float inv = 1.0f / fmaxf(sqrtf(ss), 1e-12f);
        kk = kk * inv; bb = kk * aa;
        const f32x4 gcur = g4;
        *(LAS f32x4*)(sKK + tt * 64 + 4 * cq) = kk; *(LAS f32x4*)(sW + tt * 64 + 4 * cq) = ww; *(LAS f32x4*)(sB + tt * 64 + 4 * cq) = bb;
        *(LAS f32x4*)(sKP + tt * 64 + 4 * cq) = kp; *(LAS f32x4*)(sR + tt * 64 + 4 * cq) = r4; *(LAS f32x4*)(sV + tt * 64 + 4 * cq) = vv;
        if (cq == 0) sBon[tt] = bon;
        if (c + 1 < T / 32) { base += (size_t)32 * D;
            r4 = ld4(Rp + base); k4 = ld4(Kp + base); v4 = ld4(Vp + base); wp4 = ld4(WP + base); ap4 = ld4(AP + base); g4 = ld4(GP + base);
            if (j) { vg4 = ld4(VG + base); vf4 = ld4(VF + base); } }
        __syncthreads();
#pragma unroll 2
        for (int t2 = 0; t2 < 32; ++t2) {
            const int o = t2 * 64 + 8 * kq;
            const f32x4 ka = *(const LAS f32x4*)(sKK + o), kb = *(const LAS f32x4*)(sKK + o + 4), wa = *(const LAS f32x4*)(sW + o), wb = *(const LAS f32x4*)(sW + o + 4),
                        ba = *(const LAS f32x4*)(sB + o), bb2 = *(const LAS f32x4*)(sB + o + 4), pa = *(const LAS f32x4*)(sKP + o), pb = *(const LAS f32x4*)(sKP + o + 4),
                        ra = *(const LAS f32x4*)(sR + o), rb = *(const LAS f32x4*)(sR + o + 4);
            const float vval = sV[t2 * 64 + vrow];
            float p = 0.f;
#pragma unroll
            for (int e = 0; e < 4; ++e) { p += S[e] * ka[e]; p += S[4 + e] * kb[e]; }
            p = sum8_dpp(p);
            float y = 0.f;
#pragma unroll
            for (int e = 0; e < 4; ++e) {
                S[e] = S[e] * wa[e] + (vval * pa[e] - p * ba[e]); S[4 + e] = S[4 + e] * wb[e] + (vval * pb[e] - p * bb2[e]);
                y += S[e] * ra[e]; y += S[4 + e] * rb[e]; }
            y = sum8_dpp(y);
            if (kq == 0) sY[t2 * 64 + vrow] = y;
        }
        __syncthreads();
        {
            const f32x4 y4 = *(const LAS f32x4*)(sY + tt * 64 + 4 * cq), vv4 = *(const LAS f32x4*)(sV + tt * 64 + 4 * cq); const float bo = sBon[tt];
            const float mean = sum16(sum4(y4)) * (1.0f / 64.0f); const f32x4 d = y4 - mean; const float var = sum16(sq4(d)) * (1.0f / 64.0f); const float rstd = 1.0f / sqrtf(var + GN_EPS);
            f32x4 o4;
#pragma unroll
            for (int e = 0; e < 4; ++e) o4[e] = (d[e] * rstd * lnw4[e] + lnb4[e] + bo * vv4[e]) * gcur[e];
            v2u w; w.x = pk2(o4[0], o4[1]); w.y = pk2(o4[2], o4[3]);
            *(v2u*)(YG + ((size_t)(b * T + c * 32 + tt)) * D + col) = w;
        }
        __syncthreads();
    }
    }
}

__device__ __forceinline__ float wave_sum_dpp(float x) {
    x += __builtin_bit_cast(float, __builtin_amdgcn_update_dpp(0, __builtin_bit_cast(int, x), 0xB1, 0xF, 0xF, true));
    x += __builtin_bit_cast(float, __builtin_amdgcn_update_dpp(0, __builtin_bit_cast(int, x), 0x4E, 0xF, 0xF, true));
    x += __builtin_bit_cast(float, __builtin_amdgcn_update_dpp(0, __builtin_bit_cast(int, x), 0x141, 0xF, 0xF, true));
    x += __builtin_bit_cast(float, __builtin_amdgcn_update_dpp(0, __builtin_bit_cast(int, x), 0x140, 0xF, 0xF, true));
    const int xi = __builtin_bit_cast(int, x);
    return (__builtin_bit_cast(float, __builtin_amdgcn_readlane(xi, 0)) + __builtin_bit_cast(float, __builtin_amdgcn_readlane(xi, 16))) +
           (__builtin_bit_cast(float, __builtin_amdgcn_readlane(xi, 32)) + __builtin_bit_cast(float, __builtin_amdgcn_readlane(xi, 48)));
}
__device__ __forceinline__ bf16 bf1(float x) { return (bf16)(pk2(x, x) & 0xffffu); }
__device__ __forceinline__ float fexp(float x) { return __builtin_amdgcn_exp2f(x * 1.44269504f); }
__device__ __forceinline__ float fsigm(float x) { return __builtin_amdgcn_rcpf(1.0f + __builtin_amdgcn_exp2f(-1.44269504f * x)); }
__device__ __forceinline__ float flog(float x) { return __builtin_amdgcn_logf(x) * 0.69314718f; }
__device__ __forceinline__ void rwkv_rec2(const Args& a, Frame& F, int j) {
    constexpr int CL = 32, NCH = T / CL, P64 = 144, P32 = 80;
    constexpr int O_AT = 0, O_BT = O_AT + 32 * P64, O_KT = O_BT + 32 * P64, O_RT = O_KT + 32 * P64, O_BGT = O_RT + 32 * P64, O_KGT = O_BGT + 64 * P32, O_VT = O_KGT + 64 * P32,
                  O_WT = O_VT + 64 * P32, O_UT = O_WT + 64 * P32, O_S = O_UT + 64 * P32, O_MAB = O_S + 64 * P64, O_T = O_MAB + 4096, O_MAK = O_T + 32 * P32, O_MRB = O_MAK + 32 * P32,
                  O_MRK = O_MRB + 32 * P32, O_YL = O_MRK + 32 * P32, O_TOT = O_YL + 8192, O_GL = O_TOT + 2048, O_END = O_GL + 256;
    static_assert(O_END <= RING_BYTES, "rec2 LDS map");
    for (int item = blockIdx.x; item < BATCH * NH; item += F.G) {
    const int b = item / NH, h = item % NH, lane = F.lane, w = F.wave, r = lane & 31, hh = lane >> 5;
    LAS unsigned char* L = F.lds;
    const int col = h * 64 + lane;
    const float kkc = a.in[I_KK][(size_t)j * D + col], kac = a.in[I_KA][(size_t)j * D + col], rkc = a.in[I_RK][(size_t)j * D + col], lnw = a.in[I_LNW][(size_t)j * D + col], lnb = a.in[I_LNB][(size_t)j * D + col];
    const float* Rp = (const float*)(a.ws + WS_R); const float* Kp = (const float*)(a.ws + WS_K); const float* Vp = (const float*)(a.ws + (j ? WS_V1 : WS_V0)); const float* VF = (const float*)(a.ws + WS_V0);
    const float* WP = (const float*)(a.ws + WS_LO); const float* AP = WP + (size_t)M * D; const float* GP = AP + (size_t)M * D; const float* VG = GP + (size_t)M * D;
    bf16* YG = (bf16*)(a.ws + WS_YG);
    for (int i = F.tid; i < 64 * P64 / 4; i += NWAVES * 64) ((LAS unsigned*)(L + O_S))[i] = 0u;
    f32x16 accS;
#pragma unroll
    for (int i = 0; i < 16; ++i) accS[i] = 0.f;
    float pr[4], pk[4], pv[4], pw[4], pa[4], pg[4], pvg[4], pvf[4];
    size_t base = ((size_t)(b * T + 4 * w)) * D + col;
#pragma unroll
    for (int i = 0; i < 4; ++i) { const size_t o = base + (size_t)i * D; pr[i] = Rp[o]; pk[i] = Kp[o]; pv[i] = Vp[o]; pw[i] = WP[o]; pa[i] = AP[o]; pg[i] = GP[o]; pvg[i] = j ? VG[o] : 0.f; pvf[i] = j ? VF[o] : 0.f; }
    __syncthreads();
#define RFRAG(ob, row, pitch, q) (*(const LAS bf16x8*)(L + (ob) + (row) * (pitch) + (16 * (q) + 8 * hh) * 2))
    for (int c = 0; c < NCH; ++c) {
        float aa[4], lw[4], vv[4], kkn[4], kp[4], bon[4], rr[4], gg[4], cum[4];
#pragma unroll
        for (int i = 0; i < 4; ++i) {
            aa[i] = fsigm(pa[i]);
            const float zz = -pw[i], sp = fmaxf(zz, 0.f) + flog(1.0f + fexp(-fabsf(zz)));
            lw[i] = -fexp(-sp - 0.5f);
            vv[i] = j ? pv[i] + (pvf[i] - pv[i]) * fsigm(pvg[i]) : pv[i];
            const float kk = pk[i] * kkc; const float ss = wave_sum_dpp(kk * kk);
            kkn[i] = kk * __builtin_amdgcn_rsqf(fmaxf(ss, 1e-24f));
            kp[i] = pk[i] * (1.0f + (aa[i] - 1.0f) * kac);
            bon[i] = wave_sum_dpp(pr[i] * kp[i] * rkc); rr[i] = pr[i]; gg[i] = pg[i];
        }
        cum[0] = lw[0]; cum[1] = cum[0] + lw[1]; cum[2] = cum[1] + lw[2]; cum[3] = cum[2] + lw[3];
        ((LAS float*)(L + O_TOT))[w * 64 + lane] = cum[3];
        if (c + 1 < NCH) { base += (size_t)CL * D;
#pragma unroll
            for (int i = 0; i < 4; ++i) { const size_t o = base + (size_t)i * D; pr[i] = Rp[o]; pk[i] = Kp[o]; pv[i] = Vp[o]; pw[i] = WP[o]; pa[i] = AP[o]; pg[i] = GP[o]; if (j) { pvg[i] = VG[o]; pvf[i] = VF[o]; } } }
        __syncthreads();
        {
            float off = 0.f, tot = 0.f;
#pragma unroll
            for (int ww = 0; ww < 8; ++ww) { const float tv = ((const LAS float*)(L + O_TOT))[ww * 64 + lane]; tot += tv; if (ww < w) off += tv; }
            unsigned bgp[2], kgp[2], vtp[2]; float bgv[4], kgv[4];
#pragma unroll
            for (int i = 0; i < 4; ++i) { const int t = 4 * w + i; const float cm = off + cum[i];
                const float gam = fexp(cm), gprev = fexp(cm - lw[i]), ginv = fexp(-cm), gl = fexp(tot - cm);
                *(LAS bf16*)(L + O_AT + t * P64 + lane * 2) = bf1(-kkn[i] * gprev);
                *(LAS bf16*)(L + O_BT + t * P64 + lane * 2) = bf1(kkn[i] * aa[i] * ginv);
                *(LAS bf16*)(L + O_KT + t * P64 + lane * 2) = bf1(kp[i] * ginv);
                *(LAS bf16*)(L + O_RT + t * P64 + lane * 2) = bf1(rr[i] * gam);
                bgv[i] = kkn[i] * aa[i] * gl; kgv[i] = kp[i] * gl; }
            bgp[0] = pk2(bgv[0], bgv[1]); bgp[1] = pk2(bgv[2], bgv[3]); kgp[0] = pk2(kgv[0], kgv[1]); kgp[1] = pk2(kgv[2], kgv[3]); vtp[0] = pk2(vv[0], vv[1]); vtp[1] = pk2(vv[2], vv[3]);
            *(LAS v2u*)(L + O_BGT + lane * P32 + 8 * w) = (v2u){bgp[0], bgp[1]};
            *(LAS v2u*)(L + O_KGT + lane * P32 + 8 * w) = (v2u){kgp[0], kgp[1]};
            *(LAS v2u*)(L + O_VT + lane * P32 + 8 * w) = (v2u){vtp[0], vtp[1]};
            if (w == 0) ((LAS float*)(L + O_GL))[lane] = fexp(tot);
        }
        __syncthreads();
        f32x16 accWY;
#pragma unroll
        for (int i = 0; i < 16; ++i) accWY[i] = 0.f;
        const int vh = w & 1;
        if (w < 4) {
            const int oa = (w < 2) ? O_AT : O_RT, ob = (w & 1) ? O_KT : O_BT;
#pragma unroll
            for (int q = 0; q < 4; ++q) accWY = __builtin_amdgcn_mfma_f32_32x32x16_bf16(RFRAG(oa, r, P64, q), RFRAG(ob, r, P64, q), accWY, 0, 0, 0);
            const int om = (w == 1) ? O_MAK : ((w == 2) ? O_MRB : O_MRK);
#pragma unroll
            for (int i = 0; i < 16; ++i) { const int t = (i & 3) + 8 * (i >> 2) + 4 * hh; const bool keep = (w < 2) ? (r < t) : (r <= t); const float val = keep ? accWY[i] : 0.f;
                if (w == 0) ((LAS float*)(L + O_MAB))[t * 32 + r] = val; else *(LAS bf16*)(L + om + t * P32 + r * 2) = bf1(val); }
        } else {
            const int oa = (w < 6) ? O_AT : O_RT;
#pragma unroll
            for (int q = 0; q < 4; ++q) accWY = __builtin_amdgcn_mfma_f32_32x32x16_bf16(RFRAG(oa, r, P64, q), RFRAG(O_S, 32 * vh + r, P64, q), accWY, 0, 0, 0);
        }
        __syncthreads();
        if (w == 0) {
            LAS float* TL = (LAS float*)(L + O_YL); const LAS float* MB = (const LAS float*)(L + O_MAB);
#pragma unroll 1
            for (int rb = 0; rb < 4; ++rb) {
                float acc[8];
#pragma unroll
                for (int e = 0; e < 8; ++e) acc[e] = (8 * rb + e == r) ? 1.f : 0.f;
#pragma unroll 1
                for (int s4 = 0; s4 < 2 * rb; ++s4) {
                    const float t0 = TL[(4 * s4 + 0) * 32 + r], t1 = TL[(4 * s4 + 1) * 32 + r], t2 = TL[(4 * s4 + 2) * 32 + r], t3 = TL[(4 * s4 + 3) * 32 + r];
#pragma unroll
                    for (int e = 0; e < 8; ++e) { const f32x4 m = *(const LAS f32x4*)(MB + (8 * rb + e) * 32 + 4 * s4); acc[e] += (m[0] * t0 + m[1] * t1) + (m[2] * t2 + m[3] * t3); }
                }
#pragma unroll
                for (int e = 1; e < 8; ++e) { const f32x4 m0 = *(const LAS f32x4*)(MB + (8 * rb + e) * 32 + 8 * rb), m1 = *(const LAS f32x4*)(MB + (8 * rb + e) * 32 + 8 * rb + 4);
#pragma unroll
                    for (int e2 = 0; e2 < e; ++e2) acc[e] += (e2 < 4 ? m0[e2 & 3] : m1[e2 & 3]) * acc[e2]; }
                if (hh == 0) {
#pragma unroll
                    for (int e = 0; e < 8; ++e) { TL[(8 * rb + e) * 32 + r] = acc[e]; *(LAS bf16*)(L + O_T + (8 * rb + e) * P32 + r * 2) = bf1(acc[e]); } }
                LDS_WAIT();
            }
        } else if (w >= 4) {
            const int om = (w < 6) ? O_MAK : O_MRK;
#pragma unroll
            for (int q = 0; q < 2; ++q) accWY = __builtin_amdgcn_mfma_f32_32x32x16_bf16(RFRAG(om, r, P32, q), RFRAG(O_VT, 32 * vh + r, P32, q), accWY, 0, 0, 0);
            if (w < 6) {
#pragma unroll
                for (int g = 0; g < 4; ++g) *(LAS v2u*)(L + O_WT + (32 * vh + r) * P32 + (8 * g + 4 * hh) * 2) = (v2u){pk2(accWY[4 * g], accWY[4 * g + 1]), pk2(accWY[4 * g + 2], accWY[4 * g + 3])}; }
        }
        __syncthreads();
        if (w == 4 || w == 5) {
            f32x16 accU;
#pragma unroll
            for (int i = 0; i < 16; ++i) accU[i] = 0.f;
#pragma unroll
            for (int q = 0; q < 2; ++q) accU = __builtin_amdgcn_mfma_f32_32x32x16_bf16(RFRAG(O_T, r, P32, q), RFRAG(O_WT, 32 * vh + r, P32, q), accU, 0, 0, 0);
#pragma unroll
            for (int g = 0; g < 4; ++g) *(LAS v2u*)(L + O_UT + (32 * vh + r) * P32 + (8 * g + 4 * hh) * 2) = (v2u){pk2(accU[4 * g], accU[4 * g + 1]), pk2(accU[4 * g + 2], accU[4 * g + 3])};
        }
        __syncthreads();
        if (w < 4) {
            const int kh = w >> 1;
#pragma unroll
            for (int i = 0; i < 16; ++i) accS[i] *= ((const LAS float*)(L + O_GL))[32 * kh + (i & 3) + 8 * (i >> 2) + 4 * hh];
#pragma unroll
            for (int q = 0; q < 2; ++q) { accS = __builtin_amdgcn_mfma_f32_32x32x16_bf16(RFRAG(O_BGT, 32 * kh + r, P32, q), RFRAG(O_UT, 32 * vh + r, P32, q), accS, 0, 0, 0);
                                          accS = __builtin_amdgcn_mfma_f32_32x32x16_bf16(RFRAG(O_KGT, 32 * kh + r, P32, q), RFRAG(O_VT, 32 * vh + r, P32, q), accS, 0, 0, 0); }
#pragma unroll
            for (int g = 0; g < 4; ++g) *(LAS v2u*)(L + O_S + (32 * vh + r) * P64 + (32 * kh + 8 * g + 4 * hh) * 2) = (v2u){pk2(accS[4 * g], accS[4 * g + 1]), pk2(accS[4 * g + 2], accS[4 * g + 3])};
        } else if (w >= 6) {
#pragma unroll
            for (int q = 0; q < 2; ++q) accWY = __builtin_amdgcn_mfma_f32_32x32x16_bf16(RFRAG(O_MRB, r, P32, q), RFRAG(O_UT, 32 * vh + r, P32, q), accWY, 0, 0, 0);
#pragma unroll
            for (int i = 0; i < 16; ++i) ((LAS float*)(L + O_YL))[((i & 3) + 8 * (i >> 2) + 4 * hh) * 64 + 32 * vh + r] = accWY[i];
        }
        __syncthreads();
#pragma unroll
        for (int i = 0; i < 4; ++i) { const int t = 4 * w + i; const float y = ((const LAS float*)(L + O_YL))[t * 64 + lane];
            const float mean = wave_sum_dpp(y) * (1.0f / 64.0f), d = y - mean, var = wave_sum_dpp(d * d) * (1.0f / 64.0f);
            const float o = (d * __builtin_amdgcn_rsqf(var + GN_EPS) * lnw + lnb + bon[i] * vv[i]) * gg[i];
            YG[((size_t)(b * T + c * CL + t)) * D + col] = bf1(o); }
    }
#undef RFRAG
    __syncthreads();
    }
}

namespace rc {
constexpr int CL = 32, NCH = T / CL, P64 = 144, P32 = 80;
constexpr int IM_AT = 0, IM_RT = IM_AT + 32 * P64, IM_BGT = IM_RT + 32 * P64, IM_KGT = IM_BGT + 64 * P32, IM_VT = IM_KGT + 64 * P32, IM_T = IM_VT + 64 * P32, IM_MAK = IM_T + 32 * P32,
              IM_MRB = IM_MAK + 32 * P32, IM_MRK = IM_MRB + 32 * P32, IM_GL = IM_MRK + 32 * P32, IM_BON = IM_GL + 256, IMG_BYTES = IM_BON + 128;
constexpr int IMG_PIECES = IMG_BYTES / 16, T_PIECE0 = IM_T / 16, T_PIECES = 32 * P32 / 16;
static_assert(IMG_BYTES % 16 == 0 && IM_T % 16 == 0, "image pieces");
constexpr int PO_BT = IMG_BYTES, PO_KT = PO_BT + 32 * P64, PO_MAB = PO_KT + 32 * P64, PO_TL = PO_MAB + 4096, PO_TOT = PO_TL + 4096, PO_END = PO_TOT + 2048;
constexpr int CO_WT = IMG_BYTES, CO_UT = CO_WT + 64 * P32, CO_S = CO_UT + 64 * P32, CO_YL = CO_S + 64 * P64, CO_END = CO_YL + 8192;
static_assert(PO_END <= RING_BYTES && CO_END <= RING_BYTES, "rec LDS maps");
}
__device__ __forceinline__ void rec_prep(const Args& a, Frame& F, int j) {
    using namespace rc;
    constexpr int US = PO_END;
    static_assert(2 * US <= RING_BYTES && NCH % 2 == 0, "rec_prep LDS map (two chunks)");
    const int lane = F.lane, w = F.wave, r = lane & 31, hh = lane >> 5;
    LAS unsigned char* L = F.lds;
    const bf16* Rp = (const bf16*)(a.ws + WS_R); const bf16* Kp = (const bf16*)(a.ws + WS_K); const bf16* Vp = (const bf16*)(a.ws + (j ? WS_V1 : WS_V0)); const bf16* VF = (const bf16*)(a.ws + WS_V0);
    const bf16* WP = (const bf16*)(a.ws + WS_LO); const bf16* AP = WP + (size_t)M * D; const bf16* GP = AP + (size_t)M * D; const bf16* VG = GP + (size_t)M * D;
    unsigned char* IMG = a.ws + WS_IMG;
    constexpr int NPAIR = BATCH * NH * NCH / 2;
    static_assert(2 * US + NWAVES * 2048 <= RING_BYTES, "rec_prep staging buffers");
    v4u rwR, rwK, rwV, rwW, rwA, rwG = (v4u){0u, 0u, 0u, 0u}, rwF = (v4u){0u, 0u, 0u, 0u};
    const int lrow = lane >> 3, lseg = lane & 7;
#define BF2F(x) __uint_as_float((unsigned)(x) << 16)
#define WBASE(pair_) (((size_t)(((2 * (pair_)) / NCH / NH) * T + ((2 * (pair_)) % NCH + (lrow >> 2)) * CL + 4 * w + (lrow & 3))) * D + (((2 * (pair_)) / NCH) % NH) * 64 + 8 * lseg)
#define WLD(P, o) __builtin_nontemporal_load((const v4u*)((P) + (o)))
    int pair = blockIdx.x;
    if (pair < NPAIR) { const size_t wb = WBASE(pair); rwR = WLD(Rp, wb); rwK = WLD(Kp, wb); rwV = WLD(Vp, wb); rwW = WLD(WP, wb); rwA = WLD(AP, wb); if (j) { rwG = WLD(VG, wb); rwF = *(const v4u*)(VF + wb); } }
#define RFRAG(ob, row, pitch, q) (*(const LAS bf16x8*)(L + (ob) + (row) * (pitch) + (16 * (q) + 8 * hh) * 2))
    for (; pair < NPAIR; pair += F.G) {
        const int item0 = 2 * pair, bh = item0 / NCH, h = bh % NH;
        const int col = h * 64 + lane;
        const float kkc = a.in[I_KK][(size_t)j * D + col], kac = a.in[I_KA][(size_t)j * D + col], rkc = a.in[I_RK][(size_t)j * D + col];
        float ssr[8], bonr[8];
        { const size_t cofs = (size_t)j * D + h * 64 + 8 * lseg;
          const f32x4 kk0 = ld4(a.in[I_KK] + cofs), kk1 = ld4(a.in[I_KK] + cofs + 4), ka0 = ld4(a.in[I_KA] + cofs), ka1 = ld4(a.in[I_KA] + cofs + 4), rk0 = ld4(a.in[I_RK] + cofs), rk1 = ld4(a.in[I_RK] + cofs + 4);
          const f32x4 kf0 = unb4((v2u){rwK.x, rwK.y}), kf1 = unb4((v2u){rwK.z, rwK.w}), rf0 = unb4((v2u){rwR.x, rwR.y}), rf1 = unb4((v2u){rwR.z, rwR.w}), af0 = unb4((v2u){rwA.x, rwA.y}), af1 = unb4((v2u){rwA.z, rwA.w});
          const f32x4 q0 = kf0 * kk0, q1 = kf1 * kk1;
          const f32x4 kp0 = kf0 * (1.0f + (af0 - 1.0f) * ka0), kp1 = kf1 * (1.0f + (af1 - 1.0f) * ka1);
          const float sr = sum8_dpp(sq4(q0) + sq4(q1)), br = sum8_dpp(sum4(rf0 * kp0 * rk0) + sum4(rf1 * kp1 * rk1));
#pragma unroll
          for (int q = 0; q < 8; ++q) { ssr[q] = __builtin_bit_cast(float, __builtin_amdgcn_readlane(__builtin_bit_cast(int, sr), 8 * q)); bonr[q] = __builtin_bit_cast(float, __builtin_amdgcn_readlane(__builtin_bit_cast(int, br), 8 * q)); }
        }
        unsigned short pr[2][4], pk[2][4], pv[2][4], pw[2][4], pa[2][4], pvg[2][4], pvf[2][4];
        { LAS unsigned char* stg = L + 2 * US + w * 2048;
#define UNPACK(raw, arr, bs) do { *(LAS v4u*)(stg + (bs) * 1024 + lane * 16) = raw; _Pragma("unroll") for (int q = 0; q < 8; ++q) arr[q >> 2][q & 3] = *(const LAS unsigned short*)(stg + (bs) * 1024 + q * 128 + lane * 2); } while (0)
          UNPACK(rwR, pr, 0); UNPACK(rwK, pk, 1); UNPACK(rwV, pv, 0); UNPACK(rwW, pw, 1); UNPACK(rwA, pa, 0);
          if (j) { UNPACK(rwG, pvg, 1); UNPACK(rwF, pvf, 0); }
          else {
#pragma unroll
              for (int q = 0; q < 8; ++q) { pvg[q >> 2][q & 3] = 0; pvf[q >> 2][q & 3] = 0; } }
#undef UNPACK
        }
        float aa[2][4], lw[2][4], kkn[2][4], kp[2][4], rr[2][4], cum[2][4], vv[2][4];
#pragma unroll
        for (int u = 0; u < 2; ++u) { LAS unsigned char* Lu = L + u * US;
#pragma unroll
            for (int i = 0; i < 4; ++i) { const int t = 4 * w + i;
                aa[u][i] = BF2F(pa[u][i]); lw[u][i] = BF2F(pw[u][i]);
                const float vraw = BF2F(pv[u][i]), kraw = BF2F(pk[u][i]); rr[u][i] = BF2F(pr[u][i]);
                vv[u][i] = j ? vraw + (BF2F(pvf[u][i]) - vraw) * BF2F(pvg[u][i]) : vraw;
                const float kk = kraw * kkc; const float ss = ssr[u * 4 + i];
                kkn[u][i] = kk * __builtin_amdgcn_rsqf(fmaxf(ss, 1e-24f));
                kp[u][i] = kraw * (1.0f + (aa[u][i] - 1.0f) * kac);
                if (lane == 0) ((LAS float*)(Lu + IM_BON))[t] = bonr[u * 4 + i];
            }
            cum[u][0] = lw[u][0]; cum[u][1] = cum[u][0] + lw[u][1]; cum[u][2] = cum[u][1] + lw[u][2]; cum[u][3] = cum[u][2] + lw[u][3];
            ((LAS float*)(Lu + PO_TOT))[w * 64 + lane] = cum[u][3];
        }
        __syncthreads();
        const size_t nwb = WBASE((pair + F.G < NPAIR) ? pair + F.G : pair);
#pragma unroll
        for (int u = 0; u < 2; ++u) { LAS unsigned char* Lu = L + u * US;
            float off = 0.f, tot = 0.f;
#pragma unroll
            for (int ww = 0; ww < 8; ++ww) { const float tv = ((const LAS float*)(Lu + PO_TOT))[ww * 64 + lane]; tot += tv; if (ww < w) off += tv; }
            const float gL = fexp(tot); float bgv[4], kgv[4]; float gprev = fexp(off);
#pragma unroll
            for (int i = 0; i < 4; ++i) { const int t = 4 * w + i; const float cm = off + cum[u][i];
                { constexpr int st = 0; const int sidx = u * 4 + i; (void)st;
                  if (sidx == 0) rwR = WLD(Rp, nwb); else if (sidx == 1) rwK = WLD(Kp, nwb); else if (sidx == 2) rwV = WLD(Vp, nwb); else if (sidx == 3) rwW = WLD(WP, nwb); else if (sidx == 4) rwA = WLD(AP, nwb);
                  else if (sidx == 5) { if (j) rwG = WLD(VG, nwb); } else if (sidx == 6) { if (j) rwF = *(const v4u*)(VF + nwb); }
                  __builtin_amdgcn_sched_barrier(0); }
                const float gam = fexp(cm), ginv = __builtin_amdgcn_rcpf(gam), gl = gL * ginv;
                *(LAS bf16*)(Lu + IM_AT + t * P64 + lane * 2) = bf1(-kkn[u][i] * gprev);
                *(LAS bf16*)(Lu + PO_BT + t * P64 + lane * 2) = bf1(kkn[u][i] * aa[u][i] * ginv);
                *(LAS bf16*)(Lu + PO_KT + t * P64 + lane * 2) = bf1(kp[u][i] * ginv);
                *(LAS bf16*)(Lu + IM_RT + t * P64 + lane * 2) = bf1(rr[u][i] * gam);
                bgv[i] = kkn[u][i] * aa[u][i] * gl; kgv[i] = kp[u][i] * gl; gprev = gam; }
            *(LAS v2u*)(Lu + IM_BGT + lane * P32 + 8 * w) = (v2u){pk2(bgv[0], bgv[1]), pk2(bgv[2], bgv[3])};
            *(LAS v2u*)(Lu + IM_KGT + lane * P32 + 8 * w) = (v2u){pk2(kgv[0], kgv[1]), pk2(kgv[2], kgv[3])};
            *(LAS v2u*)(Lu + IM_VT + lane * P32 + 8 * w) = (v2u){pk2(vv[u][0], vv[u][1]), pk2(vv[u][2], vv[u][3])};
            if (w == 0) ((LAS float*)(Lu + IM_GL))[lane] = gL;
        }
        __syncthreads();
        {
            const int ub = (w >> 2) * US, wq = w & 3;
            f32x16 acc;
#pragma unroll
            for (int i = 0; i < 16; ++i) acc[i] = 0.f;
            const int oa = ub + ((wq < 2) ? IM_AT : IM_RT), ob = ub + ((wq & 1) ? PO_KT : PO_BT);
#pragma unroll
            for (int q = 0; q < 4; ++q) acc = __builtin_amdgcn_mfma_f32_32x32x16_bf16(RFRAG(oa, r, P64, q), RFRAG(ob, r, P64, q), acc, 0, 0, 0);
            const int om = ub + ((wq == 1) ? IM_MAK : ((wq == 2) ? IM_MRB : IM_MRK));
#pragma unroll
            for (int i = 0; i < 16; ++i) { const int t = (i & 3) + 8 * (i >> 2) + 4 * hh; const bool keep = (wq < 2) ? (r < t) : (r <= t); const float val = keep ? acc[i] : 0.f;
                if (wq == 0) ((LAS float*)(L + ub + PO_MAB))[t * 32 + r] = val; else *(LAS bf16*)(L + om + t * P32 + r * 2) = bf1(val); }
        }
        __syncthreads();
        unsigned char* img = IMG + (size_t)item0 * IMG_BYTES;
        if (w < 2) {
            LAS unsigned char* Lu = L + w * US;
            LAS float* TL = (LAS float*)(Lu + PO_TL); const LAS float* MB = (const LAS float*)(Lu + PO_MAB);
#pragma unroll
            for (int rb = 0; rb < 4; ++rb) {
                float acc[8];
#pragma unroll
                for (int e = 0; e < 8; ++e) acc[e] = (8 * rb + e == r) ? 1.f : 0.f;
#pragma unroll
                for (int s4 = 0; s4 < 2 * rb; ++s4) {
                    const float t0 = TL[(4 * s4 + 0) * 32 + r], t1 = TL[(4 * s4 + 1) * 32 + r], t2 = TL[(4 * s4 + 2) * 32 + r], t3 = TL[(4 * s4 + 3) * 32 + r];
#pragma unroll
                    for (int e = 0; e < 8; ++e) { const f32x4 m = *(const LAS f32x4*)(MB + (8 * rb + e) * 32 + 4 * s4); acc[e] += (m[0] * t0 + m[1] * t1) + (m[2] * t2 + m[3] * t3); }
                }
#pragma unroll
                for (int e = 1; e < 8; ++e) { const f32x4 m0 = *(const LAS f32x4*)(MB + (8 * rb + e) * 32 + 8 * rb), m1 = *(const LAS f32x4*)(MB + (8 * rb + e) * 32 + 8 * rb + 4);
#pragma unroll
                    for (int e2 = 0; e2 < e; ++e2) acc[e] += (e2 < 4 ? m0[e2 & 3] : m1[e2 & 3]) * acc[e2]; }
                if (hh == 0) {
#pragma unroll
                    for (int e = 0; e < 8; ++e) { TL[(8 * rb + e) * 32 + r] = acc[e]; *(LAS bf16*)(Lu + IM_T + (8 * rb + e) * P32 + r * 2) = bf1(acc[e]); } }
                LDS_WAIT();
            }
        } else {
            for (int p = F.tid - 128; p < 2 * IMG_PIECES; p += (NWAVES - 2) * 64) { const int u = p >= IMG_PIECES, pp = p - u * IMG_PIECES;
                if (pp < T_PIECE0 || pp >= T_PIECE0 + T_PIECES) __builtin_nontemporal_store(*(const LAS v4u*)(L + u * US + pp * 16), (v4u*)(img + (size_t)u * IMG_BYTES + (size_t)pp * 16)); }
        }
        __syncthreads();
        for (int p = F.tid; p < 2 * T_PIECES; p += NWAVES * 64) { const int u = p >= T_PIECES, pp = T_PIECE0 + p - u * T_PIECES; __builtin_nontemporal_store(*(const LAS v4u*)(L + u * US + pp * 16), (v4u*)(img + (size_t)u * IMG_BYTES + (size_t)pp * 16)); }
        __syncthreads();
    }
#undef RFRAG
#undef WBASE
#undef WLD
#undef BF2F
}
__device__ __forceinline__ float sum16_dpp(float x) {
    x += __builtin_bit_cast(float, __builtin_amdgcn_update_dpp(0, __builtin_bit_cast(int, x), 0xB1, 0xF, 0xF, true));
    x += __builtin_bit_cast(float, __builtin_amdgcn_update_dpp(0, __builtin_bit_cast(int, x), 0x4E, 0xF, 0xF, true));
    x += __builtin_bit_cast(float, __builtin_amdgcn_update_dpp(0, __builtin_bit_cast(int, x), 0x141, 0xF, 0xF, true));
    x += __builtin_bit_cast(float, __builtin_amdgcn_update_dpp(0, __builtin_bit_cast(int, x), 0x140, 0xF, 0xF, true));
    return x;
}
__device__ __forceinline__ void rec_chain(const Args& a, Frame& F, int j) {
    using namespace rc;
    constexpr int IB1 = IMG_BYTES, XO = 2 * IMG_BYTES - IMG_BYTES;
    static_assert(CO_END + XO <= RING_BYTES, "rec_chain LDS map (two image buffers)");
    for (int item = blockIdx.x; item < BATCH * NH; item += F.G) {
    const int b = item / NH, h = item % NH, lane = F.lane, w = F.wave, r = lane & 31, hh = lane >> 5, vh = w & 1;
    LAS unsigned char* L = F.lds;
    const int col = h * 64 + lane;
    const int ett = F.tid >> 4, ecq = F.tid & 15, ecol = h * 64 + 4 * ecq;
    const f32x4 lnw4 = ld4(a.in[I_LNW] + (size_t)j * D + ecol), lnb4 = ld4(a.in[I_LNB] + (size_t)j * D + ecol);
    const unsigned char* IMG = a.ws + WS_IMG + (size_t)item * NCH * IMG_BYTES;
    bf16* YG = (bf16*)(a.ws + WS_YG);
    for (int i = F.tid; i < 64 * P64 / 4; i += NWAVES * 64) ((LAS unsigned*)(L + CO_S + XO))[i] = 0u;
    f32x16 accS;
#pragma unroll
    for (int i = 0; i < 16; ++i) accS[i] = 0.f;
    v4u pre[6];
#pragma unroll
    for (int k = 0; k < 6; ++k) { const int p = F.tid + k * NWAVES * 64; if (p < IMG_PIECES) *(LAS v4u*)(L + p * 16) = *(const v4u*)(IMG + (size_t)p * 16); }
#pragma unroll
    for (int k = 0; k < 6; ++k) { const int p = F.tid + k * NWAVES * 64; pre[k] = (p < IMG_PIECES) ? __builtin_nontemporal_load((const v4u*)(IMG + (size_t)IMG_BYTES + (size_t)p * 16)) : (v4u){0u, 0u, 0u, 0u}; }
    __syncthreads();
#define RFRAG(ob, row, pitch, q) (*(const LAS bf16x8*)(L + (ob) + (row) * (pitch) + (16 * (q) + 8 * hh) * 2))
    const bf16* GPc = (const bf16*)(a.ws + WS_LO) + (size_t)2 * M * D + (size_t)(b * T + ett) * D + ecol;
    v2u gcur = *(const v2u*)GPc;
    const size_t eofs = (size_t)(b * T + ett) * D + ecol;
    const bf16* VPc = (const bf16*)(a.ws + (j ? WS_V1 : WS_V0)) + eofs; const bf16* VFc = (const bf16*)(a.ws + WS_V0) + eofs; const bf16* VGc = (const bf16*)(a.ws + WS_LO) + (size_t)(j ? 3 : 2) * M * D + eofs;
    v2u vcur = *(const v2u*)VPc, vfcur = *(const v2u*)VFc, vgcur = *(const v2u*)VGc;
    for (int c = 0; c < NCH; ++c) {
        const int ib = (c & 1) * IB1, ibn = IB1 - ib;
        const size_t nofs = (size_t)((c + 1 < NCH) ? c + 1 : c) * CL * D;
        const v2u gnext = *(const v2u*)(GPc + nofs), vnext = *(const v2u*)(VPc + nofs), vfnext = *(const v2u*)(VFc + nofs), vgnext = *(const v2u*)(VGc + nofs);
        f32x16 accWY;
#pragma unroll
        for (int i = 0; i < 16; ++i) accWY[i] = 0.f;
        if (w >= 4) {
            const int oa = ib + ((w < 6) ? IM_AT : IM_RT), om = ib + ((w < 6) ? IM_MAK : IM_MRK);
#pragma unroll
            for (int q = 0; q < 4; ++q) accWY = __builtin_amdgcn_mfma_f32_32x32x16_bf16(RFRAG(oa, r, P64, q), RFRAG(CO_S + XO, 32 * vh + r, P64, q), accWY, 0, 0, 0);
#pragma unroll
            for (int q = 0; q < 2; ++q) accWY = __builtin_amdgcn_mfma_f32_32x32x16_bf16(RFRAG(om, r, P32, q), RFRAG(ib + IM_VT, 32 * vh + r, P32, q), accWY, 0, 0, 0);
            if (w < 6) {
#pragma unroll
                for (int g = 0; g < 4; ++g) *(LAS v2u*)(L + CO_WT + XO + (32 * vh + r) * P32 + (8 * g + 4 * hh) * 2) = (v2u){pk2(accWY[4 * g], accWY[4 * g + 1]), pk2(accWY[4 * g + 2], accWY[4 * g + 3])}; }
        }
        __syncthreads();
        if (c + 1 < NCH) {
#pragma unroll
            for (int k = 0; k < 6; ++k) { const int p = F.tid + k * NWAVES * 64; if (p < IMG_PIECES) *(LAS v4u*)(L + ibn + p * 16) = pre[k]; } }
        if (c + 2 < NCH) { const unsigned char* nx = IMG + (size_t)(c + 2) * IMG_BYTES;
#pragma unroll
            for (int k = 0; k < 6; ++k) { const int p = F.tid + k * NWAVES * 64; if (p < IMG_PIECES) pre[k] = __builtin_nontemporal_load((const v4u*)(nx + (size_t)p * 16)); } }
        if (w == 4 || w == 5) {
            f32x16 accU;
#pragma unroll
            for (int i = 0; i < 16; ++i) accU[i] = 0.f;
#pragma unroll
            for (int q = 0; q < 2; ++q) accU = __builtin_amdgcn_mfma_f32_32x32x16_bf16(RFRAG(ib + IM_T, r, P32, q), RFRAG(CO_WT + XO, 32 * vh + r, P32, q), accU, 0, 0, 0);
#pragma unroll
            for (int g = 0; g < 4; ++g) *(LAS v2u*)(L + CO_UT + XO + (32 * vh + r) * P32 + (8 * g + 4 * hh) * 2) = (v2u){pk2(accU[4 * g], accU[4 * g + 1]), pk2(accU[4 * g + 2], accU[4 * g + 3])};
        }
        __syncthreads();
        if (w < 4) {
            const int kh = w >> 1;
#pragma unroll
            for (int i = 0; i < 16; ++i) accS[i] *= ((const LAS float*)(L + ib + IM_GL))[32 * kh + (i & 3) + 8 * (i >> 2) + 4 * hh];
#pragma unroll
            for (int q = 0; q < 2; ++q) { accS = __builtin_amdgcn_mfma_f32_32x32x16_bf16(RFRAG(ib + IM_BGT, 32 * kh + r, P32, q), RFRAG(CO_UT + XO, 32 * vh + r, P32, q), accS, 0, 0, 0);
                                          accS = __builtin_amdgcn_mfma_f32_32x32x16_bf16(RFRAG(ib + IM_KGT, 32 * kh + r, P32, q), RFRAG(ib + IM_VT, 32 * vh + r, P32, q), accS, 0, 0, 0); }
#pragma unroll
            for (int g = 0; g < 4; ++g) *(LAS v2u*)(L + CO_S + XO + (32 * vh + r) * P64 + (32 * kh + 8 * g + 4 * hh) * 2) = (v2u){pk2(accS[4 * g], accS[4 * g + 1]), pk2(accS[4 * g + 2], accS[4 * g + 3])};
        } else if (w >= 6) {
#pragma unroll
            for (int q = 0; q < 2; ++q) accWY = __builtin_amdgcn_mfma_f32_32x32x16_bf16(RFRAG(ib + IM_MRB, r, P32, q), RFRAG(CO_UT + XO, 32 * vh + r, P32, q), accWY, 0, 0, 0);
#pragma unroll
            for (int i = 0; i < 16; ++i) ((LAS float*)(L + CO_YL + XO))[((i & 3) + 8 * (i >> 2) + 4 * hh) * 64 + 32 * vh + r] = accWY[i];
        }
        __syncthreads();
        { const f32x4 y4 = *(const LAS f32x4*)(L + CO_YL + XO + (ett * 64 + 4 * ecq) * 4);
          const v2u ggr = gcur; v2u vvr;
          { const f32x4 vr = unb4(vcur); const f32x4 vm = j ? vr + (unb4(vfcur) - vr) * unb4(vgcur) : vr; vvr = (v2u){pk2(vm[0], vm[1]), pk2(vm[2], vm[3])}; }
          const float bon = ((const LAS float*)(L + ib + IM_BON))[ett];
          const float mean = sum16_dpp(sum4(y4)) * (1.0f / 64.0f); const f32x4 d = y4 - mean;
          const float rstd = __builtin_amdgcn_rsqf(sum16_dpp(sq4(d)) * (1.0f / 64.0f) + GN_EPS);
          const f32x4 vv4 = (f32x4){__uint_as_float(vvr.x << 16), __uint_as_float(vvr.x & 0xffff0000u), __uint_as_float(vvr.y << 16), __uint_as_float(vvr.y & 0xffff0000u)};
          const f32x4 gg4 = (f32x4){__uint_as_float(ggr.x << 16), __uint_as_float(ggr.x & 0xffff0000u), __uint_as_float(ggr.y << 16), __uint_as_float(ggr.y & 0xffff0000u)};
          const f32x4 o4 = (d * rstd * lnw4 + lnb4 + vv4 * bon) * gg4;
          *(v2u*)(YG + ((size_t)(b * T + c * CL + ett)) * D + ecol) = (v2u){pk2(o4[0], o4[1]), pk2(o4[2], o4[3])}; }
        gcur = gnext; vcur = vnext; vfcur = vfnext; vgcur = vgnext;
    }
#undef RFRAG
    __syncthreads();
    }
}

__device__ __forceinline__ float swap_lo(float x) { const unsigned u = __builtin_bit_cast(unsigned, x); auto rr = __builtin_amdgcn_permlane32_swap(u, u, false, false); return __builtin_bit_cast(float, (unsigned)rr[0]); }
__device__ __forceinline__ float swap_hi(float x) { const unsigned u = __builtin_bit_cast(unsigned, x); auto rr = __builtin_amdgcn_permlane32_swap(u, u, false, false); return __builtin_bit_cast(float, (unsigned)rr[1]); }
#define S5_RSTD_PRELUDE() float* RSTD = (float*)(a.ws + WS_Z); do { \
    for (int row = F.gw; row < M; row += F.NGW) { const float sv = wave_sum_dpp(ssp[(size_t)row * SSPW + F.lane]); if (F.lane == 0) RSTD[row] = __builtin_amdgcn_rsqf(sv * (1.0f / D) + RMS_EPS); } \
    xcd_barrier(bar); } while (0)
__device__ __forceinline__ void s5_scan(const Args& a, Frame& F, int j, int li, const XcdBarrier& bar) {
    const bf16* X = (const bf16*)(a.ws + WS_XB); const float* ssp = (const float*)(a.ws + WS_SSP); bf16* YG = (bf16*)(a.ws + WS_YG);
    constexpr int NT = T / 32, NIT = BATCH * (G5 / 4);
    S5_RSTD_PRELUDE();
    for (int item = blockIdx.x; item < NIT; item += F.G) {
    const int b = item / (G5 / 4), g4 = item % (G5 / 4), lane = F.lane;
    LAS float* RS = (LAS float*)F.lds;
    for (int t = 4 * F.tid; t < T; t += NWAVES * 256) *(LAS f32x4*)(RS + t) = ld4(RSTD + (size_t)b * T + t);
    __syncthreads();
    const int pr = F.wave & 3, role = F.wave >> 2;
    const int g = 4 * g4 + pr, s = lane & 31, hh = lane >> 5, cc = lane & 15, kq = lane >> 4;
    LAS unsigned char* XI = F.lds + 32768 + pr * (2 * 8704);
    const float* gmp = a.in[I_MIX_NORM] + (size_t)li * D + 16 * g;
    if (role == 0) {
        const float dt = expf(a.in[I_LSTEP][j * G5 + g]);
        float abr[2], abi[2]; bf16x8 Bf[2][2];
#pragma unroll
        for (int bk = 0; bk < 2; ++bk) {
            const int p = s + 32 * bk; const size_t pi = (size_t)(j * G5 + g) * P5 + p;
            const float lr = fminf(a.in[I_LRE][pi], -1e-4f), lim = a.in[I_LIM][pi], zr = lr * dt, zi = lim * dt;
            const float mag = expf(zr), sn = sinf(zi), cs = cosf(zi), sh = sinf(0.5f * zi), em1 = expm1f(zr);
            abr[bk] = mag * cs; abi[bk] = mag * sn;
            const float am1 = em1 * cs - 2.0f * sh * sh, den = lr * lr + lim * lim;
            const float qr = (am1 * lr + abi[bk] * lim) / den, qi = (abi[bk] * lr - am1 * lim) / den;
            const float* br = a.in[I_BRE] + pi * C5 + 8 * hh; const float* bi = a.in[I_BIM] + pi * C5 + 8 * hh;
            const f32x4 br0 = ld4(br), br1 = ld4(br + 4), bi0 = ld4(bi), bi1 = ld4(bi + 4);
            Bf[bk][0] = pack8(br0 * qr - bi0 * qi, br1 * qr - bi1 * qi);
            Bf[bk][1] = pack8(bi0 * qr + br0 * qi, bi1 * qr + br1 * qi);
        }
        const f32x4 gA0 = ld4(gmp + 8 * hh), gA1 = ld4(gmp + 8 * hh + 4);
        const int tauA = 16 * ((s >> 2) & 1) + 4 * (s >> 3) + (s & 3);
        const bf16* xA = X + (size_t)(b * T + tauA) * D + 16 * g + 8 * hh;
        float x0r = 0.f, x0i = 0.f, x1r = 0.f, x1i = 0.f;
        v4u ra = *(const v4u*)xA, rb = *(const v4u*)(xA + (size_t)32 * D);
        f32x16 zero16;
#pragma unroll
        for (int i = 0; i < 16; ++i) zero16[i] = 0.f;
#define S5_SCAN16() do { _Pragma("unroll") for (int i = 0; i < 16; ++i) { \
                const float n0r = __builtin_fmaf(-abi[0], x0i, __builtin_fmaf(abr[0], x0r, c00[i])), n0i = __builtin_fmaf(abi[0], x0r, __builtin_fmaf(abr[0], x0i, c01[i])); x0r = n0r; x0i = n0i; c00[i] = n0r; c01[i] = n0i; \
                const float n1r = __builtin_fmaf(-abi[1], x1i, __builtin_fmaf(abr[1], x1r, c10[i])), n1i = __builtin_fmaf(abi[1], x1r, __builtin_fmaf(abr[1], x1i, c11[i])); x1r = n1r; x1i = n1i; c10[i] = n1r; c11[i] = n1i; } } while (0)
#define S5_PROD(k_, R) do { \
                const int t0 = 32 * (k_); const float rsA = RS[t0 + tauA]; \
                const bf16x8 af = pack8(unb4((v2u){R.x, R.y}) * rsA * gA0, unb4((v2u){R.z, R.w}) * rsA * gA1); \
                R = *(const v4u*)(xA + (size_t)(((k_) + 2 < NT) ? t0 + 64 : t0) * D); \
                f32x16 c00 = __builtin_amdgcn_mfma_f32_32x32x16_bf16(af, Bf[0][0], zero16, 0, 0, 0), c01 = __builtin_amdgcn_mfma_f32_32x32x16_bf16(af, Bf[0][1], zero16, 0, 0, 0); \
                f32x16 c10 = __builtin_amdgcn_mfma_f32_32x32x16_bf16(af, Bf[1][0], zero16, 0, 0, 0), c11 = __builtin_amdgcn_mfma_f32_32x32x16_bf16(af, Bf[1][1], zero16, 0, 0, 0); \
                if (hh == 0) S5_SCAN16(); \
                x0r = swap_lo(x0r); x0i = swap_lo(x0i); x1r = swap_lo(x1r); x1i = swap_lo(x1i);       \
                if (hh == 1) S5_SCAN16(); \
                x0r = swap_hi(x0r); x0i = swap_hi(x0i); x1r = swap_hi(x1r); x1i = swap_hi(x1i);       \
                LAS unsigned char* XB_ = XI + ((k_) & 1) * 8704; \
                _Pragma("unroll") for (int i = 0; i < 16; ++i) { v2u w; w.x = pk2(c00[i], c01[i]); w.y = pk2(c10[i], c11[i]); *(LAS v2u*)(XB_ + (16 * hh + i) * 272 + 8 * s) = w; } } while (0)
        for (int k = 0; k < NT; k += 2) { S5_PROD(k, ra); __syncthreads(); S5_PROD(k + 1, rb); __syncthreads(); }
        __syncthreads();
#undef S5_PROD
#undef S5_SCAN16
    } else {
        bf16x8 Cf[4];
#pragma unroll
        for (int ks = 0; ks < 4; ++ks) { float cv[8];
#pragma unroll
            for (int e = 0; e < 8; ++e) { const int k = 32 * ks + 8 * kq + e, sp2 = k >> 2, comp = k & 3, p = sp2 + ((comp & 2) ? 32 : 0); const size_t ci = ((size_t)(j * G5 + g) * C5 + cc) * P5 + p;
                cv[e] = (comp & 1) ? -a.in[I_CIM][ci] : a.in[I_CRE][ci]; }
            Cf[ks] = pack8((f32x4){cv[0], cv[1], cv[2], cv[3]}, (f32x4){cv[4], cv[5], cv[6], cv[7]}); }
        const f32x4 gE = ld4(gmp + 4 * kq), dsk = ld4(a.in[I_S5D] + (size_t)j * D + 16 * g + 4 * kq);
        const bf16* xE = X + (size_t)(b * T + cc) * D + 16 * g + 4 * kq;
        bf16* yo = YG + (size_t)(b * T + cc) * D + 16 * g + 4 * kq;
        v2u e0 = *(const v2u*)xE, e1 = *(const v2u*)(xE + (size_t)16 * D), f0 = *(const v2u*)(xE + (size_t)32 * D), f1 = *(const v2u*)(xE + (size_t)48 * D);
#define S5_CONS(k_, E0, E1) do { \
                const int t0 = 32 * ((k_) - 1); const f32x4 ev0 = unb4(E0), ev1 = unb4(E1); \
                { const size_t tn = (size_t)(((k_) + 1 < NT) ? t0 + 64 : t0) * D; E0 = *(const v2u*)(xE + tn); E1 = *(const v2u*)(xE + tn + (size_t)16 * D); } \
                const LAS unsigned char* XB_ = XI + (((k_) - 1) & 1) * 8704; \
                _Pragma("unroll") for (int tb = 0; tb < 2; ++tb) { \
                    f32x4 ay = (f32x4){0.f, 0.f, 0.f, 0.f}; \
                    _Pragma("unroll") for (int ks = 0; ks < 4; ++ks) { const bf16x8 xf = *(const LAS bf16x8*)(XB_ + (16 * tb + cc) * 272 + 64 * ks + 16 * kq); ay = __builtin_amdgcn_mfma_f32_16x16x32_bf16(Cf[ks], xf, ay, 0, 0, 0); } \
                    const f32x4 ev = tb ? ev1 : ev0; const float rsE = RS[t0 + 16 * tb + cc]; \
                    const f32x4 u = ev * rsE * gE; f32x4 yv = ay + dsk * u; \
                    _Pragma("unroll") for (int e = 0; e < 4; ++e) { const float y = yv[e]; yv[e] = y * pg8::fast_sigmoid(1.5957691216f * (y + 0.044715f * y * y * y)); } \
                    v2u w; w.x = pk2(yv[0], yv[1]); w.y = pk2(yv[2], yv[3]); \
                    *(v2u*)(yo + (size_t)(t0 + 16 * tb) * D) = w; } } while (0)
        __syncthreads();
        for (int k = 1; k <= NT; k += 2) { S5_CONS(k, e0, e1); __syncthreads(); S5_CONS(k + 1, f0, f1); __syncthreads(); }
#undef S5_CONS
    }
    }
    if (j == 0 && (int)blockIdx.x >= NIT && F.G > NIT) convert_set(a, F.lane, (LAS float*)(F.lds + F.wave * 16384), 2, ((int)blockIdx.x - NIT) * NWAVES + F.wave, (F.G - NIT) * NWAVES);
}

__device__ __forceinline__ void s5_scan2(const Args& a, Frame& F, int j, int li, const XcdBarrier& bar) {
    const bf16* X = (const bf16*)(a.ws + WS_XB); const float* ssp = (const float*)(a.ws + WS_SSP); bf16* YG = (bf16*)(a.ws + WS_YG);
    constexpr int NT = T / 32, NIT = BATCH * (G5 / 2);
    S5_RSTD_PRELUDE();
    for (int it = blockIdx.x; it < NIT; it += F.G) {
    const int item = (F.G == NIT) ? (it & 7) * (NIT / 8) + (it >> 3) : it;
    const int b = item / (G5 / 2), g2 = item % (G5 / 2), lane = F.lane;
    LAS float* RS = (LAS float*)F.lds;
    for (int t = 4 * F.tid; t < T; t += NWAVES * 256) *(LAS f32x4*)(RS + t) = ld4(RSTD + (size_t)b * T + t);
    __syncthreads();
    const int pr = F.wave & 1, role = (F.wave < 4) ? 0 : ((F.wave < 6) ? 1 : 2), bk = (F.wave >> 1) & 1;
    const int g = 2 * g2 + pr, s = lane & 31, hh = lane >> 5, cc = lane & 15, kq = lane >> 4;
    LAS unsigned char* XI = F.lds + 32768 + pr * (2 * 8704);
    const float* gmp = a.in[I_MIX_NORM] + (size_t)li * D + 16 * g;
    if (role == 0) {
        const float dt = expf(a.in[I_LSTEP][j * G5 + g]);
        float abr, abi; bf16x8 Bf[2];
        {
            const int p = s + 32 * bk; const size_t pi = (size_t)(j * G5 + g) * P5 + p;
            const float lr = fminf(a.in[I_LRE][pi], -1e-4f), lim = a.in[I_LIM][pi], zr = lr * dt, zi = lim * dt;
            const float mag = expf(zr), sn = sinf(zi), cs = cosf(zi), sh = sinf(0.5f * zi), em1 = expm1f(zr);
            abr = mag * cs; abi = mag * sn;
            const float am1 = em1 * cs - 2.0f * sh * sh, den = lr * lr + lim * lim;
            const float qr = (am1 * lr + abi * lim) / den, qi = (abi * lr - am1 * lim) / den;
            const float* br = a.in[I_BRE] + pi * C5 + 8 * hh; const float* bi = a.in[I_BIM] + pi * C5 + 8 * hh;
            const f32x4 br0 = ld4(br), br1 = ld4(br + 4), bi0 = ld4(bi), bi1 = ld4(bi + 4);
            Bf[0] = pack8(br0 * qr - bi0 * qi, br1 * qr - bi1 * qi);
            Bf[1] = pack8(bi0 * qr + br0 * qi, bi1 * qr + br1 * qi);
        }
        const f32x4 gA0 = ld4(gmp + 8 * hh), gA1 = ld4(gmp + 8 * hh + 4);
        const int tauA = 16 * ((s >> 2) & 1) + 4 * (s >> 3) + (s & 3);
        const bf16* xA = X + (size_t)(b * T + tauA) * D + 16 * g + 8 * hh;
        float xr = 0.f, xi = 0.f;
        v4u ra = *(const v4u*)xA, rb = *(const v4u*)(xA + (size_t)32 * D);
        f32x16 zero16;
#pragma unroll
        for (int i = 0; i < 16; ++i) zero16[i] = 0.f;
#define S5_SCAN16H() do { _Pragma("unroll") for (int i = 0; i < 16; ++i) { \
                const float nr = __builtin_fmaf(-abi, xi, __builtin_fmaf(abr, xr, c0[i])), ni = __builtin_fmaf(abi, xr, __builtin_fmaf(abr, xi, c1[i])); xr = nr; xi = ni; c0[i] = nr; c1[i] = ni; } } while (0)
#define S5_PROD(k_, R) do { \
                const int t0 = 32 * (k_); const float rsA = RS[t0 + tauA]; \
                const bf16x8 af = pack8(unb4((v2u){R.x, R.y}) * rsA * gA0, unb4((v2u){R.z, R.w}) * rsA * gA1); \
                R = *(const v4u*)(xA + (size_t)(((k_) + 2 < NT) ? t0 + 64 : t0) * D); \
                f32x16 c0 = __builtin_amdgcn_mfma_f32_32x32x16_bf16(af, Bf[0], zero16, 0, 0, 0), c1 = __builtin_amdgcn_mfma_f32_32x32x16_bf16(af, Bf[1], zero16, 0, 0, 0); \
                if (hh == 0) S5_SCAN16H(); \
                xr = swap_lo(xr); xi = swap_lo(xi);                                     \
                if (hh == 1) S5_SCAN16H(); \
                xr = swap_hi(xr); xi = swap_hi(xi);                                     \
                LAS unsigned char* XB_ = XI + ((k_) & 1) * 8704; \
                _Pragma("unroll") for (int i = 0; i < 16; ++i) *(LAS unsigned*)(XB_ + (16 * hh + i) * 272 + 8 * s + 4 * bk) = pk2(c0[i], c1[i]); } while (0)
        for (int k = 0; k < NT; k += 2) { S5_PROD(k, ra); __syncthreads(); S5_PROD(k + 1, rb); __syncthreads(); }
        __syncthreads();
#undef S5_PROD
#undef S5_SCAN16H
    } else if (role == 1) {
        bf16x8 Cf[4];
#pragma unroll
        for (int ks = 0; ks < 4; ++ks) { float cv[8];
#pragma unroll
            for (int e = 0; e < 8; ++e) { const int k = 32 * ks + 8 * kq + e, sp2 = k >> 2, comp = k & 3, p = sp2 + ((comp & 2) ? 32 : 0); const size_t ci = ((size_t)(j * G5 + g) * C5 + cc) * P5 + p;
                cv[e] = (comp & 1) ? -a.in[I_CIM][ci] : a.in[I_CRE][ci]; }
            Cf[ks] = pack8((f32x4){cv[0], cv[1], cv[2], cv[3]}, (f32x4){cv[4], cv[5], cv[6], cv[7]}); }
        const f32x4 gE = ld4(gmp + 4 * kq), dsk = ld4(a.in[I_S5D] + (size_t)j * D + 16 * g + 4 * kq);
        const bf16* xE = X + (size_t)(b * T + cc) * D + 16 * g + 4 * kq;
        bf16* yo = YG + (size_t)(b * T + cc) * D + 16 * g + 4 * kq;
        v2u e0 = *(const v2u*)xE, e1 = *(const v2u*)(xE + (size_t)16 * D), f0 = *(const v2u*)(xE + (size_t)32 * D), f1 = *(const v2u*)(xE + (size_t)48 * D);
#define S5_CONS(k_, E0, E1) do { \
                const int t0 = 32 * ((k_) - 1); const f32x4 ev0 = unb4(E0), ev1 = unb4(E1); \
                { const size_t tn = (size_t)(((k_) + 1 < NT) ? t0 + 64 : t0) * D; E0 = *(const v2u*)(xE + tn); E1 = *(const v2u*)(xE + tn + (size_t)16 * D); } \
                const LAS unsigned char* XB_ = XI + (((k_) - 1) & 1) * 8704; \
                _Pragma("unroll") for (int tb = 0; tb < 2; ++tb) { \
                    f32x4 ay = (f32x4){0.f, 0.f, 0.f, 0.f}; \
                    _Pragma("unroll") for (int ks = 0; ks < 4; ++ks) { const bf16x8 xf = *(const LAS bf16x8*)(XB_ + (16 * tb + cc) * 272 + 64 * ks + 16 * kq); ay = __builtin_amdgcn_mfma_f32_16x16x32_bf16(Cf[ks], xf, ay, 0, 0, 0); } \
                    const f32x4 ev = tb ? ev1 : ev0; const float rsE = RS[t0 + 16 * tb + cc]; \
                    const f32x4 u = ev * rsE * gE; f32x4 yv = ay + dsk * u; \
                    _Pragma("unroll") for (int e = 0; e < 4; ++e) { const float y = yv[e]; yv[e] = y * pg8::fast_sigmoid(1.5957691216f * (y + 0.044715f * y * y * y)); } \
                    v2u w; w.x = pk2(yv[0], yv[1]); w.y = pk2(yv[2], yv[3]); \
                    *(v2u*)(yo + (size_t)(t0 + 16 * tb) * D) = w; } } while (0)
        __syncthreads();
        for (int k = 1; k <= NT; k += 2) { S5_CONS(k, e0, e1); __syncthreads(); S5_CONS(k + 1, f0, f1); __syncthreads(); }
#undef S5_CONS
    } else {
        for (int k = 0; k <= NT; ++k) __syncthreads();
    }
    }
}

__device__ __forceinline__ void final_norm(const Args& a, Frame& F) {
    const float* ssp = (const float*)(a.ws + WS_SSP); const float* g = a.in[I_FNORM]; const bf16* XB = (const bf16*)(a.ws + WS_XB);
    for (int row = F.gw; row < M; row += F.NGW) {
        const float rs = __builtin_amdgcn_rsqf(wave_sum(ssp[(size_t)row * SSPW + F.lane]) * (1.0f / D) + RMS_EPS);
        float* xo = a.out + (size_t)row * D + 4 * F.lane; const bf16* xi = XB + (size_t)row * D + 4 * F.lane;
#pragma unroll 4
        for (int q = 0; q < 16; ++q) { const f32x4 v = ldb4(xi + 256 * q) * rs * ld4(g + 256 * q + 4 * F.lane); __builtin_nontemporal_store(v, (f32x4*)(xo + 256 * q)); }
    }
}

constexpr int NPH = 82;
#ifndef MK_MULTI
#define MK_MULTI 0
#endif
#define EPI_STAGGER() do { if (((int)blockIdx.x >> 3) & 1) { __builtin_amdgcn_s_sleep(127); __builtin_amdgcn_s_sleep(127); } } while (0)
template <int hl> __device__ __forceinline__ void run_hl(const Args& a, Frame& F, const XcdBarrier& bar) {
#define RUN(k) (a.ph_lo <= (k) && (k) < a.ph_hi)
#define SEAM(k) do { if ((k) + 1 < a.ph_hi) xcd_barrier(bar); } while (0)
    unsigned char* ws = a.ws;
    float* SSP = (float*)(ws + WS_SSP); bf16* XB = (bf16*)(ws + WS_XB); bf16* ACT = (bf16*)(ws + WS_ACT); bf16* YG = (bf16*)(ws + WS_YG);
    const int cid = (int)blockIdx.x;

        constexpr int L = hl >> 1, sidx = hl & 1, base = 1 + hl * 10;
        if (RUN(base)) {
            const int nssp = (sidx == 1 && (L & 1)) ? 128 : 64;
            pg8::Gemm g{XB, (const bf16*)(ws + WS_WIN) + (size_t)hl * 2 * FF * D, M, 2 * FF, D, 1, 0, 0}; pg8::StaticOrder S; S.init(M, 2 * FF, 1, F.G, cid);
            pg8::Unit u0; S.next(0, u0);
            { LAS float* rsl = (LAS float*)(F.lds + RSL_OFF); const int row = u0.pm * 256 + (F.tid >> 1), hf = F.tid & 1; const float* sp = SSP + (size_t)row * SSPW + hf * (nssp >> 1); float s = 0.f;
              for (int q = 0; q < (nssp >> 3); ++q) s += sum4(ld4(sp + 4 * q));
              s += __shfl_xor(s, 1);
              if (hf == 0) rsl[F.tid >> 1] = __builtin_amdgcn_rsqf(s * (1.0f / D) + RMS_EPS);
              __syncthreads(); }
            pg8::EpiSwiglu E{ACT, FF, SSP, nssp, (const LAS float*)(F.lds + RSL_OFF), u0.pm};
            REPX(REP_G1, pg8::gemm_phase<pg8::EpiSwiglu, pg8::StaticOrder, true, true>(F.lds, g, S, E));
            SEAM(base);
        }
        if (RUN(base + 1)) {
            pg8::Gemm g{ACT, (const bf16*)(ws + WS_WOUT) + (size_t)hl * D * FF, M, D, FF, 1, 0, 0}; pg8::StaticOrder S; S.init(M, D, 1, F.G, cid);
            EPI_STAGGER();
            pg8::EpiResid E{XB, SSP, 0.5f};
            { pg8::EpiDry ED{a.out}; REPX(REP_G2DRY, pg8::gemm_phase<pg8::EpiDry, pg8::StaticOrder, true, true>(F.lds, g, S, ED)); }
            pg8::gemm_phase<pg8::EpiResid, pg8::StaticOrder, true, true>(F.lds, g, S, E);
            SEAM(base + 1);
        }
        if constexpr (sidx == 0) {
            constexpr int j = L >> 1;
            if constexpr ((L & 1) == 0) {
                if (RUN(base + 2)) { REPX(REP_RMISC, rwkv_prep(a, F, j, L)); SEAM(base + 2); }
                if (RUN(base + 3)) { {
                    { pg8::Gemm g{(const bf16*)(ws + WS_XR), (const bf16*)(ws + WS_WRKV) + (size_t)j * 3 * D * D, M, D, D, 3, (size_t)M * D, (size_t)D * D}; pg8::StaticOrder S; S.init(M, D, 3, F.G, cid);
                      pg8::EpiAct E{(bf16*)(ws + WS_R), (bf16*)(ws + WS_K), (bf16*)(ws + (j ? WS_V1 : WS_V0)), nullptr, D, nullptr, 0, 0, 0, 0, 0};
                      REPX(REP_RMISC, pg8::gemm_phase<pg8::EpiAct, pg8::StaticOrder, true, true>(F.lds, g, S, E)); }
                    { pg8::Gemm g{(const bf16*)(ws + WS_HB), (const bf16*)(ws + WS_WL1) + (size_t)j * 1024 * D, M, 1024, D, 1, 0, 0}; pg8::StaticOrder S; S.init(M, 1024, 1, F.G, cid);
                      pg8::EpiStore E{(float*)(ws + WS_Z), nullptr, nullptr, nullptr, 1024, nullptr, 0};
                      REPX(REP_RMISC, pg8::gemm_phase<pg8::EpiStore, pg8::StaticOrder, true, true>(F.lds, g, S, E)); }
                    } SEAM(base + 3);
                }
                if (RUN(base + 4)) { REPX(REP_RMISC, rwkv_mid(a, F, j)); SEAM(base + 4); }
                if (RUN(base + 5)) {
                    const int KL = 128 + (F.G >> 20);
                    pg8::Gemm g{(const bf16*)(ws + WS_MID), (const bf16*)(ws + WS_WL2) + (size_t)j * 4 * D * 128, M, D, KL, j ? 4 : 3, (size_t)M * 128, (size_t)D * 128}; pg8::StaticOrder S; S.init(M, D, j ? 4 : 3, F.G, cid);
                    bf16* LO = (bf16*)(ws + WS_LO);
                    pg8::EpiAct E{LO, LO + (size_t)M * D, LO + (size_t)2 * M * D, LO + (size_t)3 * M * D, D, (const float*)(ws + WS_BIAS) + (size_t)j * 4 * D, D, 2, 1, 0, 1};
                    REPX(REP_RMISC, pg8::gemm_phase<pg8::EpiAct, pg8::StaticOrder, true, true>(F.lds, g, S, E));
                    SEAM(base + 5);
                }
                if (RUN(base + 6)) { REPX(REP_PREP, rec_prep(a, F, j)); SEAM(base + 6); }
                if (RUN(base + 7)) { REPX(REP_REC, rec_chain(a, F, j));
                    if ((int)blockIdx.x >= BATCH * NH && F.G > BATCH * NH) convert_set(a, F.lane, (LAS float*)(F.lds + F.wave * 16384), j ? 3 : 1, ((int)blockIdx.x - BATCH * NH) * NWAVES + F.wave, (F.G - BATCH * NH) * NWAVES);
                    SEAM(base + 7); }
                if (RUN(base + 8)) {
                    pg8::Gemm g{YG, (const bf16*)(ws + WS_WO) + (size_t)j * D * D, M, D, D, 1, 0, 0}; pg8::StaticOrder S; S.init(M, D, 1, F.G, cid);
                    EPI_STAGGER();
                    pg8::EpiResid E{XB, SSP, 1.0f};
                    { pg8::EpiDry ED{a.out}; REPX(REP_G2DRY, pg8::gemm_phase<pg8::EpiDry, pg8::StaticOrder, true, true>(F.lds, g, S, ED)); }
                    pg8::gemm_phase<pg8::EpiResid, pg8::StaticOrder, true, true>(F.lds, g, S, E);
                    SEAM(base + 8);
                }
            } else {
                if (RUN(base + 2)) { if constexpr (j == 1) { if (F.G >= BATCH * (G5 / 2)) { REPX(REP_S5, s5_scan2(a, F, j, L, bar)); } else { REPX(REP_S5, s5_scan(a, F, j, L, bar)); } } else { REPX(REP_S5, s5_scan(a, F, j, L, bar)); } SEAM(base + 2); }
                if (RUN(base + 3)) {
                    pg8::Gemm g{YG, (const bf16*)(ws + WS_WGLU) + (size_t)j * 2 * D * D, M, 2 * D, D, 1, 0, 0}; pg8::StaticOrder S; S.init(M, 2 * D, 1, F.G, cid);
                    EPI_STAGGER();
                    pg8::EpiGluResid E{XB, SSP};
                    { pg8::EpiDry ED{a.out}; REPX(REP_G2DRY, pg8::gemm_phase<pg8::EpiDry, pg8::StaticOrder, true, true>(F.lds, g, S, ED)); }
                    pg8::gemm_phase<pg8::EpiGluResid, pg8::StaticOrder, true, true>(F.lds, g, S, E);
                    SEAM(base + 3);
                }
            }
        }

#undef RUN
#undef SEAM
}
__global__ void __launch_bounds__(NWAVES * 64, 2) fwd(Args a) {
    extern __shared__ __attribute__((aligned(16))) unsigned char lds[];
    Frame F; F.lds = (LAS unsigned char*)lds; F.tid = threadIdx.x; F.lane = F.tid & 63; F.wave = __builtin_amdgcn_readfirstlane(F.tid >> 6);
    F.G = gridDim.x; F.gw = blockIdx.x * NWAVES + F.wave; F.NGW = F.G * NWAVES;
    volatile LAS unsigned* CTLW = (volatile LAS unsigned*)(F.lds + LDSCTL_OFF);
    if (F.tid < 64) CTLW[F.tid] = 0u;
    __syncthreads();
    XcdBarrier bar; bar.bar = (unsigned*)(a.ws + WS_CTL) + CW_BAR; bar.x = 0; bar.st = nullptr;
    const bool multi_phase = (a.ph_hi - a.ph_lo) > 1;
    if (multi_phase) bar = xcd_barrier_post((unsigned*)(a.ws + WS_CTL) + CW_BAR, CTLW + 8);
#define RUN(k) (a.ph_lo <= (k) && (k) < a.ph_hi)
#define SEAM(k) do { if ((k) + 1 < a.ph_hi) xcd_barrier(bar); } while (0)
    unsigned char* ws = a.ws;
    float* SSP = (float*)(ws + WS_SSP); bf16* XB = (bf16*)(ws + WS_XB); bf16* ACT = (bf16*)(ws + WS_ACT); bf16* YG = (bf16*)(ws + WS_YG);
    const int cid = (int)blockIdx.x;

    if (RUN(0)) { REPX(REP_PRO, p0_prologue(a, F)); SEAM(0); }

    run_hl<0>(a, F, bar); run_hl<1>(a, F, bar); run_hl<2>(a, F, bar); run_hl<3>(a, F, bar); run_hl<4>(a, F, bar); run_hl<5>(a, F, bar); run_hl<6>(a, F, bar); run_hl<7>(a, F, bar);
    if (RUN(NPH - 1)) final_norm(a, F);
#undef RUN
#undef SEAM
}

static bool phase_empty(int k) {
    if (k == 0 || k == NPH - 1) return false;
    const int hl = (k - 1) / 10, off = (k - 1) % 10;
    if (off < 2) return false;
    if (hl & 1) return true;
    const int L = hl >> 1;
    if (L & 1) return off >= 4;
    return off >= 9;
}
extern "C" void kernel_launch(void* const* d_in, const int* in_sizes, int n_in, void* d_out, int out_size, void* d_ws, size_t ws_size, hipStream_t stream) {
    static int grid = 0;
    if (grid == 0) {
        if (n_in != 34 || out_size != M * D || ws_size < WS_END) { fprintf(stderr, "kernel_launch: unexpected shapes (n_in %d, out %d, ws %zu < %zu)\n", n_in, out_size, ws_size, (size_t)WS_END); grid = -1; return; }
        int dev = 0, cus = 0, per_cu = 0;
        if (hipGetDevice(&dev) != hipSuccess || hipDeviceGetAttribute(&cus, hipDeviceAttributeMultiprocessorCount, dev) != hipSuccess) { grid = -1; return; }
        if (hipFuncSetAttribute((const void*)fwd, hipFuncAttributeMaxDynamicSharedMemorySize, LDS_BYTES) != hipSuccess) { fprintf(stderr, "kernel_launch: hipFuncSetAttribute failed\n"); grid = -1; return; }
        if (hipOccupancyMaxActiveBlocksPerMultiprocessor(&per_cu, (const void*)fwd, NWAVES * 64, LDS_BYTES) != hipSuccess || per_cu < 1) { fprintf(stderr, "kernel_launch: occupancy query says %d\n", per_cu); }
        (void)hipGetLastError();
        grid = cus;
    }
    if (grid < 0) return;
    (void)hipMemsetAsync((char*)d_ws + WS_CTL, 0, CTL_ZERO_BYTES, stream);
    Args a{};
    for (int i = 0; i < 34; ++i) a.in[i] = (const float*)d_in[i];
    a.out = (float*)d_out; a.ws = (unsigned char*)d_ws;
#if MK_MULTI
    for (int k = 0; k < NPH; ++k) { if (phase_empty(k)) continue; a.ph_lo = k; a.ph_hi = k + 1; hipLaunchKernelGGL(fwd, dim3(grid), dim3(NWAVES * 64), LDS_BYTES, stream, a); }
#else
    a.ph_lo = 0; a.ph_hi = NPH; hipLaunchKernelGGL(fwd, dim3(grid), dim3(NWAVES * 64), LDS_BYTES, stream, a);
#endif
}
```

```cpp
#include <hip/hip_runtime.h>
#include <cstdio>
#include <cstdint>
#define REPX(n, ...) do { if constexpr ((n) >= 1) { __VA_ARGS__; } if constexpr ((n) >= 2) { __VA_ARGS__; } if constexpr ((n) >= 3) { __VA_ARGS__; } } while (0)
#ifndef REP_G1
#define REP_G1 1
#endif
#ifndef REP_G2DRY
#define REP_G2DRY 0
#endif
#ifndef REP_REC
#define REP_REC 1
#endif
#ifndef REP_PREP
#define REP_PREP 1
#endif
#ifndef REP_PRO
#define REP_PRO 1
#endif
#ifndef REP_RMISC
#define REP_RMISC 1
#endif
#ifndef REP_S5
#define REP_S5 1
#endif

#define GAS __attribute__((address_space(1)))
#define LAS __attribute__((address_space(3)))
#define PG8_LAS __attribute__((address_space(3)))

constexpr int BATCH = 2, T = 8192, D = 4096, M = BATCH * T, DEPTH = 4, FF = 6144;
constexpr int NH = 64, HN = 64;
constexpr int G5 = 256, P5 = 64, C5 = 16;
constexpr int WL = 128, AL = 128, VL = 96, GL = 96;
constexpr float RMS_EPS = 1e-6f, GN_EPS = 64e-5f;
constexpr int NWAVES = 8;
constexpr int SSPW = 128;

namespace pg8 {
typedef unsigned short bf16_t;
typedef short bf16x8 __attribute__((ext_vector_type(8)));
typedef float f32x4 __attribute__((ext_vector_type(4)));
typedef unsigned u32x4 __attribute__((ext_vector_type(4)));
constexpr int BM = 256, BK = 64, HALF = 128, HTB = HALF * BK * 2  , STAGE_BYTES = 8 * HTB, NXCD = 8, WGM = 8;

__host__ __device__ __forceinline__ int lds_byte(int r, int c) { const int st = (r >> 4) * 2 + (c >> 5), rr = r & 15, cc = c & 31, ob = rr * 64 + cc * 2; return st * 1024 + (ob ^ (((ob >> 9) & 1) << 5)); }
__host__ __device__ __forceinline__ void stage_rc(int b, int& R, int& C) { const int st = b / 1024, sb = b % 1024, swz = sb ^ (((sb >> 9) & 1) << 5); R = (st >> 1) * 16 + swz / 64; C = (st & 1) * 32 + (swz % 64) / 2; }
__host__ __device__ __forceinline__ int perm32(int rho) { const int n = rho >> 4, i = rho & 15; return 8 * (i >> 2) + 4 * n + (i & 3); }

struct Unit { int pm, pn, z; };
struct Gemm { const bf16_t* A; const bf16_t* Bt; int M, N, K, nz; size_t sAz, sBz; };

struct StaticOrder {
    int nM, nN, nwg, G, c, nz;
    __host__ __device__ void init(int M_, int N_, int nz_, int G_, int c_) { nM = M_ / BM; nN = N_ / BM; nwg = nM * nN; G = G_; c = c_; nz = nz_; }
    __host__ __device__ bool next(int i, Unit& u) const {
        const long L = (long)i * G + c; if (L >= (long)nwg * nz) return false;
        u.z = (int)(L / nwg);
        int wgid = (int)(L % nwg); { const int q = nwg / NXCD, r = nwg % NXCD, xcd = wgid % NXCD, off = wgid / NXCD; wgid = (xcd < r ? xcd * (q + 1) : r * (q + 1) + (xcd - r) * q) + off; }
        const int nig = WGM * nN, gid = wgid / nig, fm = gid * WGM, gsz = (nM - fm) < WGM ? (nM - fm) : WGM;
        u.pm = fm + ((wgid % nig) % gsz); u.pn = (wgid % nig) / gsz; return true;
    }
    __device__ __forceinline__ void a_ready(const Unit&) const {}
    __device__ __forceinline__ void done(const Unit&) const {}
};

typedef __bf16 bf16pair_t __attribute__((ext_vector_type(2)));
__device__ __forceinline__ unsigned cvt_pk_bf16(float lo, float hi) { bf16pair_t v; v[0] = (__bf16)lo; v[1] = (__bf16)hi; return __builtin_bit_cast(unsigned, v); }
__device__ __forceinline__ float fast_sigmoid(float x) { return __builtin_amdgcn_rcpf(1.0f + __builtin_amdgcn_exp2f(-1.44269504f * x)); }
__device__ __forceinline__ float sum4(const f32x4 v) { return (v[0] + v[1]) + (v[2] + v[3]); }
__device__ __forceinline__ float sq4(const f32x4 v) { return (v[0] * v[0] + v[1] * v[1]) + (v[2] * v[2] + v[3] * v[3]); }

struct EpiStore {
    static constexpr bool PERM = true, AFTER_DRAIN = false;
    float* o0; float* o1; float* o2; float* o3; int ldc; const float* bias; int bias_stride;
    __device__ __forceinline__ void operator()(const f32x4 (&acc)[2][2][4][2], const Unit& u, int wr, int wc, int fr, int fq) const {
        float* O = u.z == 0 ? o0 : (u.z == 1 ? o1 : (u.z == 2 ? o2 : o3));
        const int row0 = u.pm * BM + wr * 64 + fr, col0 = u.pn * BM + wc * 32 + 8 * fq;
        f32x4 bv[2][2];
#pragma unroll
        for (int bj = 0; bj < 2; ++bj)
#pragma unroll
            for (int n = 0; n < 2; ++n) bv[bj][n] = bias ? *(const f32x4*)(bias + (size_t)u.z * bias_stride + col0 + bj * HALF + 4 * n) : (f32x4){0.f, 0.f, 0.f, 0.f};
#pragma unroll
        for (int ai = 0; ai < 2; ++ai)
#pragma unroll
            for (int m = 0; m < 4; ++m) { float* rowp = O + (size_t)(row0 + ai * HALF + m * 16) * ldc + col0;
#pragma unroll
                for (int bj = 0; bj < 2; ++bj) { *(f32x4*)(rowp + bj * HALF) = acc[ai][bj][m][0] + bv[bj][0]; *(f32x4*)(rowp + bj * HALF + 4) = acc[ai][bj][m][1] + bv[bj][1]; } }
    }
};
struct EpiAct {
    static constexpr bool PERM = true, AFTER_DRAIN = false;
    bf16_t* o0; bf16_t* o1; bf16_t* o2; bf16_t* o3; int ldc; const float* bias; int bias_stride; int m0, m1, m2, m3;
    __device__ __forceinline__ static float act(float x, int mode) {
        if (mode == 1) return fast_sigmoid(x);
        if (mode == 2) { const float zz = -x, sp = fmaxf(zz, 0.f) + __builtin_amdgcn_logf(1.0f + __builtin_amdgcn_exp2f(-1.44269504f * fabsf(zz))) * 0.69314718f; return -__builtin_amdgcn_exp2f(1.44269504f * (-sp - 0.5f)); }
        return x;
    }
    __device__ __forceinline__ void operator()(const f32x4 (&acc)[2][2][4][2], const Unit& u, int wr, int wc, int fr, int fq) const {
        bf16_t* O = u.z == 0 ? o0 : (u.z == 1 ? o1 : (u.z == 2 ? o2 : o3)); const int mode = u.z == 0 ? m0 : (u.z == 1 ? m1 : (u.z == 2 ? m2 : m3));
        const int row0 = u.pm * BM + wr * 64 + fr, col0 = u.pn * BM + wc * 32 + 8 * fq;
        f32x4 bv[2][2];
#pragma unroll
        for (int bj = 0; bj < 2; ++bj)
#pragma unroll
            for (int n = 0; n < 2; ++n) bv[bj][n] = bias ? *(const f32x4*)(bias + (size_t)u.z * bias_stride + col0 + bj * HALF + 4 * n) : (f32x4){0.f, 0.f, 0.f, 0.f};
#pragma unroll
        for (int ai = 0; ai < 2; ++ai)
#pragma unroll
            for (int m = 0; m < 4; ++m) { bf16_t* rowp = O + (size_t)(row0 + ai * HALF + m * 16) * ldc + col0;
#pragma unroll
                for (int bj = 0; bj < 2; ++bj) { const f32x4 v0 = acc[ai][bj][m][0] + bv[bj][0], v1 = acc[ai][bj][m][1] + bv[bj][1];
                    float o0 = v0[0], o1 = v0[1], o2 = v0[2], o3 = v0[3], o4 = v1[0], o5 = v1[1], o6 = v1[2], o7 = v1[3];
                    if (mode == 1) { o0 = fast_sigmoid(o0); o1 = fast_sigmoid(o1); o2 = fast_sigmoid(o2); o3 = fast_sigmoid(o3); o4 = fast_sigmoid(o4); o5 = fast_sigmoid(o5); o6 = fast_sigmoid(o6); o7 = fast_sigmoid(o7); }
                    else if (mode == 2) { o0 = act(o0, 2); o1 = act(o1, 2); o2 = act(o2, 2); o3 = act(o3, 2); o4 = act(o4, 2); o5 = act(o5, 2); o6 = act(o6, 2); o7 = act(o7, 2); }
                    u32x4 w; w.x = cvt_pk_bf16(o0, o1); w.y = cvt_pk_bf16(o2, o3); w.z = cvt_pk_bf16(o4, o5); w.w = cvt_pk_bf16(o6, o7);
                    *(u32x4*)(rowp + bj * HALF) = w; } }
    }
};
__device__ __forceinline__ float row_rstd(const float* ssp, int nssp, int row, int fq) {
    const float* sp = ssp + (size_t)row * SSPW + fq * (nssp >> 2); float s = 0.f;
    for (int q = 0; q < (nssp >> 4); ++q) s += sum4(*(const f32x4*)(sp + 4 * q));
    s += __shfl_xor(s, 16); s += __shfl_xor(s, 32);
    return __builtin_amdgcn_rsqf(s * (1.0f / D) + RMS_EPS);
}
struct EpiSwiglu {
    static constexpr bool PERM = true, AFTER_DRAIN = false;
    bf16_t* O; int ldc; const float* ssp; int nssp; const PG8_LAS float* rsl; int pm0;
    __device__ __forceinline__ void operator()(const f32x4 (&acc)[2][2][4][2], const Unit& u, int wr, int wc, int fr, int fq) const {
        const int row0 = u.pm * BM + wr * 64 + fr, col0 = u.pn * HALF + wc * 32 + 8 * fq;
        float rsv[2][4];
        if (u.pm == pm0) {
#pragma unroll
            for (int ai = 0; ai < 2; ++ai)
#pragma unroll
                for (int m = 0; m < 4; ++m) rsv[ai][m] = rsl[wr * 64 + fr + ai * HALF + m * 16];
        } else {
#pragma unroll
            for (int ai = 0; ai < 2; ++ai)
#pragma unroll
                for (int m = 0; m < 4; ++m) rsv[ai][m] = row_rstd(ssp, nssp, row0 + ai * HALF + m * 16, fq);
        }
#pragma unroll
        for (int ai = 0; ai < 2; ++ai)
#pragma unroll
            for (int m = 0; m < 4; ++m) { const int row = row0 + ai * HALF + m * 16; const float rs = rsv[ai][m];
                float o[8];
#pragma unroll
                for (int n = 0; n < 2; ++n)
#pragma unroll
                    for (int e = 0; e < 4; ++e) { const float g = acc[ai][0][m][n][e] * rs, up = acc[ai][1][m][n][e] * rs; o[4 * n + e] = g * fast_sigmoid(g) * up; }
                u32x4 w; w.x = cvt_pk_bf16(o[0], o[1]); w.y = cvt_pk_bf16(o[2], o[3]); w.z = cvt_pk_bf16(o[4], o[5]); w.w = cvt_pk_bf16(o[6], o[7]);
                *(u32x4*)(O + (size_t)row * ldc + col0) = w; }
    }
};
__device__ __forceinline__ float bflo(unsigned u) { return __uint_as_float(u << 16); }
__device__ __forceinline__ float bfhi(unsigned u) { return __uint_as_float(u & 0xffff0000u); }
struct EpiResid {
    static constexpr bool PERM = true, AFTER_DRAIN = false;
    bf16_t* XB; float* ssp; float scale;
    __device__ __forceinline__ void operator()(const f32x4 (&acc)[2][2][4][2], const Unit& u, int wr, int wc, int fr, int fq) const {
        const int row0 = u.pm * BM + wr * 64 + fr, col0 = u.pn * BM + wc * 32 + 8 * fq;
#pragma unroll
        for (int ai = 0; ai < 2; ++ai) {
            u32x4 xv[4][2];
#pragma unroll
            for (int m = 0; m < 4; ++m)
#pragma unroll
                for (int bj = 0; bj < 2; ++bj) xv[m][bj] = *(const u32x4*)(XB + (size_t)(row0 + ai * HALF + m * 16) * D + col0 + bj * HALF);
#pragma unroll
            for (int m = 0; m < 4; ++m) { const int row = row0 + ai * HALF + m * 16; float ss = 0.f;
#pragma unroll
                for (int bj = 0; bj < 2; ++bj) { const u32x4 xr = xv[m][bj];
                    const f32x4 x0 = (f32x4){bflo(xr.x), bfhi(xr.x), bflo(xr.y), bfhi(xr.y)} + acc[ai][bj][m][0] * scale, x1 = (f32x4){bflo(xr.z), bfhi(xr.z), bflo(xr.w), bfhi(xr.w)} + acc[ai][bj][m][1] * scale;
                    ss += sq4(x0) + sq4(x1);
                    u32x4 w; w.x = cvt_pk_bf16(x0[0], x0[1]); w.y = cvt_pk_bf16(x0[2], x0[3]); w.z = cvt_pk_bf16(x1[0], x1[1]); w.w = cvt_pk_bf16(x1[2], x1[3]);
                    *(u32x4*)(XB + (size_t)row * D + col0 + bj * HALF) = w; }
                ss += __shfl_xor(ss, 16); ss += __shfl_xor(ss, 32);
                if (fq == 0) ssp[(size_t)row * SSPW + u.pn * 4 + wc] = ss; }
        }
    }
};
struct EpiGluResid {
    static constexpr bool PERM = true, AFTER_DRAIN = false;
    bf16_t* XB; float* ssp;
    __device__ __forceinline__ void operator()(const f32x4 (&acc)[2][2][4][2], const Unit& u, int wr, int wc, int fr, int fq) const {
        const int row0 = u.pm * BM + wr * 64 + fr, col0 = u.pn * HALF + wc * 32 + 8 * fq;
        u32x4 xv[2][4];
#pragma unroll
        for (int ai = 0; ai < 2; ++ai)
#pragma unroll
            for (int m = 0; m < 4; ++m) xv[ai][m] = *(const u32x4*)(XB + (size_t)(row0 + ai * HALF + m * 16) * D + col0);
#pragma unroll
        for (int ai = 0; ai < 2; ++ai)
#pragma unroll
            for (int m = 0; m < 4; ++m) { const int row = row0 + ai * HALF + m * 16; const u32x4 xr = xv[ai][m];
                f32x4 x0 = (f32x4){bflo(xr.x), bfhi(xr.x), bflo(xr.y), bfhi(xr.y)}, x1 = (f32x4){bflo(xr.z), bfhi(xr.z), bflo(xr.w), bfhi(xr.w)};
#pragma unroll
                for (int e = 0; e < 4; ++e) { x0[e] += acc[ai][0][m][0][e] * fast_sigmoid(acc[ai][1][m][0][e]); x1[e] += acc[ai][0][m][1][e] * fast_sigmoid(acc[ai][1][m][1][e]); }
                float ss = sq4(x0) + sq4(x1);
                u32x4 w; w.x = cvt_pk_bf16(x0[0], x0[1]); w.y = cvt_pk_bf16(x0[2], x0[3]); w.z = cvt_pk_bf16(x1[0], x1[1]); w.w = cvt_pk_bf16(x1[2], x1[3]);
                *(u32x4*)(XB + (size_t)row * D + col0) = w;
                ss += __shfl_xor(ss, 16); ss += __shfl_xor(ss, 32);
                if (fq == 0) ssp[(size_t)row * SSPW + u.pn * 4 + wc] = ss; }
    }
};
struct EpiDry {
    static constexpr bool PERM = true, AFTER_DRAIN = false;
    float* X;
    __device__ __forceinline__ void operator()(const f32x4 (&acc)[2][2][4][2], const Unit& u, int wr, int wc, int fr, int fq) const {
        float s = 0.f;
#pragma unroll
        for (int ai = 0; ai < 2; ++ai)
#pragma unroll
            for (int bj = 0; bj < 2; ++bj)
#pragma unroll
                for (int m = 0; m < 4; ++m) { s += sum4(acc[ai][bj][m][0]); s += sum4(acc[ai][bj][m][1]); }
        if (s == 1234.56789f) X[u.pm] = s;
    }
};
template <class Epi, class Sched, bool ALIGN_EPI = false, bool SP2 = false>
__device__ __forceinline__ void gemm_phase(PG8_LAS unsigned char* lds, const Gemm g, const Sched& S, const Epi& E) {
    const int tid = threadIdx.x, wid = __builtin_amdgcn_readfirstlane(tid >> 6), lane = tid & 63, wr = wid >> 2, wc = wid & 3, fr = lane & 15, fq = lane >> 4;
    const int K = g.K, nt = K / BK;
    unsigned voffA[2], voffB[2];
#pragma unroll
    for (int i = 0; i < 2; ++i) { int R, C; stage_rc(tid * 16 + i * 8192, R, C); const int Rb = Epi::PERM ? ((R & ~31) + perm32(R & 31)) : R;
        voffA[i] = (unsigned)(R * K + C) * 2u; voffB[i] = (unsigned)(Rb * K + C) * 2u; }
    const size_t kstep = (size_t)(BK * 2);
    const size_t hstep = (size_t)HALF * K * 2;
    const size_t tstep = 2 * hstep;
    const unsigned ldsw = (unsigned)wid * 1024u;
    const int aoff = lds_byte(wr * 64 + fr, fq * 8), boff = lds_byte(wc * 32 + fr, fq * 8);
#define PG8_SA(b, h) (((b) * 2 + (h)) * HTB)
#define PG8_SB(b, h) ((4 + (b) * 2 + (h)) * HTB)
#define PG8_STAGE(bufoff, gbase, voff) do { _Pragma("unroll") for (int _i = 0; _i < 2; ++_i) \
        __builtin_amdgcn_global_load_lds((const unsigned*)((const char*)(gbase) + (voff)[_i]), (PG8_LAS unsigned*)(lds + (bufoff) + ldsw + _i * 8192), 16, 0, 0); } while (0)
#define PG8_LDA(dst, b, h) do { _Pragma("unroll") for (int m = 0; m < 4; ++m) _Pragma("unroll") for (int k = 0; k < 2; ++k) dst[m][k] = *(const PG8_LAS bf16x8*)(lds + PG8_SA(b, h) + aoff + m * 2048 + k * 1024); } while (0)
#define PG8_LDB(dst, b, h) do { _Pragma("unroll") for (int n = 0; n < 2; ++n) _Pragma("unroll") for (int k = 0; k < 2; ++k) dst[n][k] = *(const PG8_LAS bf16x8*)(lds + PG8_SB(b, h) + boff + n * 2048 + k * 1024); } while (0)
#define PG8_MMA(ai, bj, At, Bt) do { __builtin_amdgcn_s_setprio(1); _Pragma("unroll") for (int m = 0; m < 4; ++m) _Pragma("unroll") for (int n = 0; n < 2; ++n) _Pragma("unroll") for (int k = 0; k < 2; ++k) \
        acc[ai][bj][m][n] = __builtin_amdgcn_mfma_f32_16x16x32_bf16(Bt[n][k], At[m][k], acc[ai][bj][m][n], 0, 0, 0); __builtin_amdgcn_s_setprio(0); } while (0)
#define PG8_WAIT_V(n) asm volatile("s_waitcnt vmcnt(" #n ")" ::: "memory")
#define PG8_WAIT_L(n) asm volatile("s_waitcnt lgkmcnt(" #n ")" ::: "memory")
#define PG8_BAR __builtin_amdgcn_s_barrier()
#define PG8_SCHED __builtin_amdgcn_sched_barrier(0)
    Unit cur, nxt; int ui = 0;
    if (!S.next(0, cur)) return;
    f32x4 acc[2][2][4][2];
#pragma unroll
    for (int a = 0; a < 2; ++a)
#pragma unroll
        for (int b = 0; b < 2; ++b)
#pragma unroll
            for (int m = 0; m < 4; ++m)
#pragma unroll
                for (int n = 0; n < 2; ++n) acc[a][b][m][n] = (f32x4){0.f, 0.f, 0.f, 0.f};
    bf16x8 At[4][2], B0[2][2], B1[2][2];
    const char* cA = (const char*)g.A + (size_t)cur.z * g.sAz * 2 + (size_t)cur.pm * tstep; const char* cB = (const char*)g.Bt + (size_t)cur.z * g.sBz * 2 + (size_t)cur.pn * tstep;
    S.a_ready(cur);
    if constexpr (SP2) {
        PG8_STAGE(PG8_SB(0, 0), cB, voffB); PG8_STAGE(PG8_SB(0, 1), cB + hstep, voffB); PG8_STAGE(PG8_SA(0, 0), cA, voffA); PG8_STAGE(PG8_SA(0, 1), cA + hstep, voffA);
        if (wr == 1) PG8_BAR;
        PG8_WAIT_V(2); PG8_BAR;
        PG8_STAGE(PG8_SB(1, 0), cB + kstep, voffB); PG8_STAGE(PG8_SA(1, 0), cA + kstep, voffA); PG8_STAGE(PG8_SB(1, 1), cB + hstep + kstep, voffB);
        PG8_WAIT_V(6); PG8_BAR;
    } else {
        PG8_STAGE(PG8_SB(0, 0), cB, voffB); PG8_STAGE(PG8_SA(0, 0), cA, voffA); PG8_STAGE(PG8_SB(0, 1), cB + hstep, voffB); PG8_STAGE(PG8_SA(0, 1), cA + hstep, voffA);
        if (wr == 1) PG8_BAR;
        PG8_WAIT_V(4); PG8_BAR;
        PG8_STAGE(PG8_SB(1, 0), cB + kstep, voffB); PG8_STAGE(PG8_SA(1, 0), cA + kstep, voffA); PG8_STAGE(PG8_SB(1, 1), cB + hstep + kstep, voffB);
        PG8_WAIT_V(6); PG8_BAR;
    }
    for (;;) {
        const bool has_next = S.next(ui + 1, nxt);
        const char* nA = has_next ? (const char*)g.A + (size_t)nxt.z * g.sAz * 2 + (size_t)nxt.pm * tstep : cA; const char* nB = has_next ? (const char*)g.Bt + (size_t)nxt.z * g.sBz * 2 + (size_t)nxt.pn * tstep : cB;
        for (int t = 0; t < nt; t += 2) {
            const bool last = (t == nt - 2);
            const char* a1 = cA + (size_t)(t + 1) * kstep;
            const char* a2 = last ? nA : cA + (size_t)(t + 2) * kstep; const char* b2 = last ? nB : cB + (size_t)(t + 2) * kstep;
            const char* a3 = a2 + kstep; const char* b3 = b2 + kstep;
            if (last && has_next) S.a_ready(nxt);
            if constexpr (SP2) {
            PG8_LDB(B0, 0, 0); PG8_LDB(B1, 0, 1); PG8_SCHED; PG8_LDA(At, 0, 0); PG8_STAGE(PG8_SA(1, 1), a1 + hstep, voffA);
            PG8_WAIT_V(8); PG8_WAIT_L(0); PG8_BAR; PG8_MMA(0, 0, At, B0); PG8_MMA(0, 1, At, B1); PG8_BAR; PG8_SCHED;
            PG8_LDA(At, 0, 1); PG8_STAGE(PG8_SB(0, 0), b2, voffB); PG8_STAGE(PG8_SB(0, 1), b2 + hstep, voffB); PG8_STAGE(PG8_SA(0, 0), a2, voffA);
            PG8_WAIT_V(8); PG8_WAIT_L(0); PG8_BAR; PG8_MMA(1, 0, At, B0); PG8_MMA(1, 1, At, B1); PG8_BAR; PG8_SCHED;
            PG8_LDB(B0, 1, 0); PG8_LDB(B1, 1, 1); PG8_SCHED; PG8_LDA(At, 1, 0); PG8_STAGE(PG8_SA(0, 1), a2 + hstep, voffA);
            PG8_WAIT_V(8); PG8_WAIT_L(0); PG8_BAR; PG8_MMA(0, 0, At, B0); PG8_MMA(0, 1, At, B1); PG8_BAR; PG8_SCHED;
            PG8_LDA(At, 1, 1); PG8_STAGE(PG8_SB(1, 0), b3, voffB); PG8_STAGE(PG8_SB(1, 1), b3 + hstep, voffB); PG8_STAGE(PG8_SA(1, 0), a3, voffA);
            PG8_WAIT_V(8); PG8_WAIT_L(0); PG8_BAR; PG8_MMA(1, 0, At, B0); PG8_MMA(1, 1, At, B1); PG8_BAR; PG8_SCHED;
            } else {
            PG8_LDB(B0, 0, 0); PG8_SCHED; PG8_LDA(At, 0, 0); PG8_STAGE(PG8_SA(1, 1), a1 + hstep, voffA);
            PG8_WAIT_L(8); PG8_BAR; PG8_WAIT_L(0); PG8_MMA(0, 0, At, B0); PG8_BAR; PG8_SCHED;
            PG8_LDB(B1, 0, 1); PG8_STAGE(PG8_SB(0, 0), b2, voffB);
            PG8_BAR; PG8_WAIT_L(0); PG8_MMA(0, 1, At, B1); PG8_BAR;
            PG8_LDA(At, 0, 1); PG8_STAGE(PG8_SA(0, 0), a2, voffA);
            PG8_BAR; PG8_WAIT_L(0); PG8_MMA(1, 0, At, B0); PG8_BAR; PG8_SCHED;
            PG8_STAGE(PG8_SB(0, 1), b2 + hstep, voffB);
            PG8_WAIT_V(6); PG8_BAR; PG8_MMA(1, 1, At, B1); PG8_BAR;
            PG8_LDB(B0, 1, 0); PG8_SCHED; PG8_LDA(At, 1, 0); PG8_STAGE(PG8_SA(0, 1), a2 + hstep, voffA);
            PG8_WAIT_L(8); PG8_BAR; PG8_WAIT_L(0); PG8_MMA(0, 0, At, B0); PG8_BAR; PG8_SCHED;
            PG8_LDB(B1, 1, 1); PG8_STAGE(PG8_SB(1, 0), b3, voffB);
            PG8_BAR; PG8_WAIT_L(0); PG8_MMA(0, 1, At, B1); PG8_BAR;
            PG8_LDA(At, 1, 1); PG8_STAGE(PG8_SA(1, 0), a3, voffA);
            PG8_BAR; PG8_WAIT_L(0); PG8_MMA(1, 0, At, B0); PG8_BAR; PG8_SCHED;
            PG8_STAGE(PG8_SB(1, 1), b3 + hstep, voffB);
            PG8_WAIT_V(6); PG8_BAR; PG8_MMA(1, 1, At, B1); PG8_BAR;
            }
        }
        if constexpr (ALIGN_EPI) { if (wr == 0) PG8_BAR; }
        if constexpr (!Epi::AFTER_DRAIN) { E(acc, cur, wr, wc, fr, fq); S.done(cur); }
        if (!has_next) break;
#pragma unroll
        for (int a = 0; a < 2; ++a)
#pragma unroll
            for (int b = 0; b < 2; ++b)
#pragma unroll
                for (int m = 0; m < 4; ++m)
#pragma unroll
                    for (int n = 0; n < 2; ++n) acc[a][b][m][n] = (f32x4){0.f, 0.f, 0.f, 0.f};
        cur = nxt; cA = nA; cB = nB; ++ui;
        if constexpr (ALIGN_EPI) { if (wr == 1) PG8_BAR; }
    }
    PG8_WAIT_V(0);
    if constexpr (!ALIGN_EPI) { if (wr == 0) PG8_BAR; }
    PG8_BAR;
    if constexpr (Epi::AFTER_DRAIN) { E.fused(acc, cur, wr, wc, fr, fq, lds, wid, lane); S.done(cur); }
#undef PG8_SA
#undef PG8_SB
#undef PG8_STAGE
#undef PG8_LDA
#undef PG8_LDB
#undef PG8_MMA
#undef PG8_WAIT_V
#undef PG8_WAIT_L
#undef PG8_BAR
#undef PG8_SCHED
}
}

typedef unsigned short bf16;
typedef unsigned v4u __attribute__((ext_vector_type(4)));
typedef unsigned v2u __attribute__((ext_vector_type(2)));
typedef float f32x4 __attribute__((ext_vector_type(4)));
typedef float f32x16 __attribute__((ext_vector_type(16)));
typedef short bf16x8 __attribute__((ext_vector_type(8)));
#define LDS_WAIT() asm volatile("s_waitcnt lgkmcnt(0)" ::: "memory")
#define VM_WAIT() asm volatile("s_waitcnt vmcnt(0)" ::: "memory")
__device__ __forceinline__ unsigned pk2(float lo, float hi) { return pg8::cvt_pk_bf16(lo, hi); }
__device__ __forceinline__ f32x4 ld4(const float* p) { return *(const f32x4*)p; }
__device__ __forceinline__ f32x4 unb4(const v2u u) { return (f32x4){__uint_as_float(u.x << 16), __uint_as_float(u.x & 0xffff0000u), __uint_as_float(u.y << 16), __uint_as_float(u.y & 0xffff0000u)}; }
__device__ __forceinline__ f32x4 ldb4(const unsigned short* p) { const v2u u = *(const v2u*)p; return (f32x4){__uint_as_float(u.x << 16), __uint_as_float(u.x & 0xffff0000u), __uint_as_float(u.y << 16), __uint_as_float(u.y & 0xffff0000u)}; }
__device__ __forceinline__ float sum4(const f32x4 v) { return (v[0] + v[1]) + (v[2] + v[3]); }
__device__ __forceinline__ float sq4(const f32x4 v) { return (v[0] * v[0] + v[1] * v[1]) + (v[2] * v[2] + v[3] * v[3]); }
__device__ __forceinline__ float wave_sum(float v) {
#pragma unroll
    for (int o = 1; o < 64; o <<= 1) v += __shfl_xor(v, o);
    return v;
}
__device__ __forceinline__ float sum16(float v) { v += __shfl_xor(v, 1); v += __shfl_xor(v, 2); v += __shfl_xor(v, 4); v += __shfl_xor(v, 8); return v; }
__device__ __forceinline__ float sum8_dpp(float x) {
    x += __builtin_bit_cast(float, __builtin_amdgcn_update_dpp(0, __builtin_bit_cast(int, x), 0xB1, 0xF, 0xF, true));
    x += __builtin_bit_cast(float, __builtin_amdgcn_update_dpp(0, __builtin_bit_cast(int, x), 0x4E, 0xF, 0xF, true));
    x += __builtin_bit_cast(float, __builtin_amdgcn_update_dpp(0, __builtin_bit_cast(int, x), 0x141, 0xF, 0xF, true));
    return x;
}
__device__ __forceinline__ float sigmoid_p(float x) { return 1.0f / (1.0f + expf(-x)); }
__device__ __forceinline__ bf16x8 pack8(const f32x4 a, const f32x4 b) { v4u w; w.x = pk2(a[0], a[1]); w.y = pk2(a[2], a[3]); w.z = pk2(b[0], b[1]); w.w = pk2(b[2], b[3]); return __builtin_bit_cast(bf16x8, w); }

constexpr size_t MiB = 1u << 20;
constexpr size_t WS_CTL = 0, CTL_ZERO_BYTES = 1 * MiB;
constexpr size_t WS_SSP = 1 * MiB;
constexpr size_t WS_BIAS = 9 * MiB;
constexpr size_t WS_WIN = 16 * MiB;
constexpr size_t WS_WOUT = WS_WIN + 768 * MiB;
constexpr size_t WS_WRKV = WS_WOUT + 384 * MiB;
constexpr size_t WS_WO = WS_WRKV + 192 * MiB;
constexpr size_t WS_WGLU = WS_WO + 64 * MiB;
constexpr size_t WS_WL1 = WS_WGLU + 128 * MiB;
constexpr size_t WS_WL2 = WS_WL1 + 16 * MiB;
constexpr size_t WS_XB = WS_WL2 + 16 * MiB;
constexpr size_t WS_ACT = WS_XB + 128 * MiB;
constexpr size_t WS_XR = WS_ACT + 192 * MiB;
constexpr size_t WS_HB = WS_XR + 384 * MiB;
constexpr size_t WS_Z = WS_HB + 128 * MiB;
constexpr size_t WS_MID = WS_Z + 64 * MiB;
constexpr size_t WS_R = WS_MID + 32 * MiB;
constexpr size_t WS_K = WS_R + 256 * MiB;
constexpr size_t WS_V0 = WS_K + 256 * MiB;
constexpr size_t WS_V1 = WS_V0 + 256 * MiB;
constexpr size_t WS_LO = WS_V1 + 256 * MiB;
constexpr size_t WS_YG = WS_LO + 1024 * MiB;
constexpr size_t WS_IMG = WS_YG + 128 * MiB;
constexpr size_t WS_END = WS_IMG + 680 * MiB;
constexpr int CW_BAR = 4096;

constexpr int RING_BYTES = 131072;
constexpr int LDSCTL_OFF = RING_BYTES;
constexpr int RSL_OFF = RING_BYTES + 1024;
constexpr int LDS_BYTES = 147456;

#define XB_TMO      128
#define XB_XCNT(j)  (256  + 64 * (j))
#define XB_XSUB(j)  (1280 + 64 * (j))
#define XB_XGEN(j)  (2304 + 64 * (j))
#define XB_TOP      3328
#define XB_TOPGEN   3392
#define XCD_BAR_WORDS 3456
#define XB_SPIN_CAP (1u << 18)

__device__ __forceinline__ unsigned xb_ld(unsigned* p)              { return __hip_atomic_load(p, __ATOMIC_RELAXED, __HIP_MEMORY_SCOPE_AGENT); }
__device__ __forceinline__ unsigned xb_add(unsigned* p, unsigned v) { return __hip_atomic_fetch_add(p, v, __ATOMIC_RELAXED, __HIP_MEMORY_SCOPE_AGENT); }
__device__ __forceinline__ unsigned xb_xcc_id() { return (unsigned)__builtin_amdgcn_s_getreg((3 << 11) | 20) & 0xFu; }
#define XB_SPIN(cond, bar) do { unsigned _sp = 0; while (cond) { __builtin_amdgcn_s_sleep(1); \
    if ((++_sp & 255u) == 0u) { if (xb_ld(&(bar)[XB_TMO])) break; if (_sp > XB_SPIN_CAP) { atomicAdd(&(bar)[XB_TMO], 1u); break; } } } } while (0)

struct XcdBarrier {
    unsigned* bar; unsigned x;
    volatile LAS unsigned* st;
};

__device__ __forceinline__ XcdBarrier xcd_barrier_post(unsigned* bar, volatile LAS unsigned* st) {
    XcdBarrier b; b.bar = bar; b.x = xb_xcc_id(); b.st = st;
    if (threadIdx.x == 0) (void)xb_add(&bar[XB_XCNT(b.x)], 1u);
    return b;
}
__device__ __forceinline__ void xcd_barrier_complete(unsigned* bar, unsigned x, unsigned& nloc, unsigned& nx) {
    const unsigned G = gridDim.x * gridDim.y * gridDim.z;
    unsigned sum, cnt, mine, sp = 0u;
    for (;;) {
        sum = 0u; cnt = 0u; mine = 0u;
#pragma unroll
        for (unsigned j = 0; j < 16; ++j) { const unsigned c = xb_ld(&bar[XB_XCNT(j)]); sum += c; cnt += (c > 0u) ? 1u : 0u; mine = (j == x) ? c : mine; }
        if (sum == G) break;
        __builtin_amdgcn_s_sleep(1);
        if ((++sp & 255u) == 0u) { if (xb_ld(&bar[XB_TMO])) break; if (sp > XB_SPIN_CAP) { atomicAdd(&bar[XB_TMO], 1u); break; } }
    }
    nloc = mine > 0u ? mine : 1u; nx = cnt > 0u ? cnt : 1u;
}

__device__ __forceinline__ void xcd_barrier(const XcdBarrier& b) {
    asm volatile("s_waitcnt vmcnt(0)" ::: "memory");
    __syncthreads();
    if (threadIdx.x == 0) {
        unsigned* bar = b.bar;
        __builtin_amdgcn_s_waitcnt(0);
        unsigned nloc = b.st[0], nx = b.st[1];
        if (nloc == 0u) { xcd_barrier_complete(bar, b.x, nloc, nx); b.st[0] = nloc; b.st[1] = nx; }
        const unsigned old = xb_add(&bar[XB_XSUB(b.x)], 1u);
        const unsigned gen = old / nloc;
        if (old + 1u == (gen + 1u) * nloc) {
            __builtin_amdgcn_fence(__ATOMIC_RELEASE, "agent");
            asm volatile("s_waitcnt vmcnt(0)" ::: "memory");
            const unsigned og = xb_add(&bar[XB_TOP], 1u);
            const unsigned tg = og / nx;
            if (og + 1u == (tg + 1u) * nx) xb_add(&bar[XB_TOPGEN], 1u);
            else XB_SPIN(xb_ld(&bar[XB_TOPGEN]) == tg, bar);
            __builtin_amdgcn_fence(__ATOMIC_ACQUIRE, "agent");
            xb_add(&bar[XB_XGEN(b.x)], 1u);
            asm volatile("s_waitcnt vmcnt(0)" ::: "memory");
        } else {
            XB_SPIN(xb_ld(&bar[XB_XGEN(b.x)]) == gen, bar);
            __builtin_amdgcn_fence(__ATOMIC_ACQUIRE, "agent");
            asm volatile("s_waitcnt vmcnt(0)" ::: "memory");
        }
    }
    __syncthreads();
}

struct Args { const float* in[34]; float* out; unsigned char* ws; int ph_lo, ph_hi; };
struct Frame { LAS unsigned char* lds; int tid, lane, wave, G, gw, NGW; };
enum { I_X = 0, I_FFN_NORM, I_FFN_WIN, I_FFN_WOUT, I_MIX_NORM, I_MU, I_WRKV, I_WO, I_W0, I_WL1, I_WL2, I_A0, I_AL1, I_AL2, I_V0, I_VL1, I_VL2, I_GL1, I_GL2, I_KK, I_KA, I_RK, I_LNW, I_LNB,
       I_LRE, I_LIM, I_LSTEP, I_BRE, I_BIM, I_CRE, I_CIM, I_S5D, I_WGLU, I_FNORM };

struct TrDesc { const float* src; bf16* dst; const float* scale; int ldw, K; };
__device__ __forceinline__ TrDesc tr_decode(const Args& a, int it) {
    unsigned char* ws = a.ws;
    constexpr int IT_IN = (D / 64) * (2 * FF / 32), IT_OUT = (FF / 64) * (D / 32), IT_SQ = (D / 64) * (D / 32), IT_GLU = (D / 64) * (2 * D / 32);
    constexpr int N_IN = 8 * IT_IN, N_OUT = 8 * IT_OUT, N_RKV = 6 * IT_SQ, N_O = 2 * IT_SQ;
    const int cat = it < N_IN ? 0 : (it < N_IN + N_OUT ? 1 : (it < N_IN + N_OUT + N_RKV ? 2 : (it < N_IN + N_OUT + N_RKV + N_O ? 3 : 4)));
    const int r0 = it - (cat == 0 ? 0 : (cat == 1 ? N_IN : (cat == 2 ? N_IN + N_OUT : (cat == 3 ? N_IN + N_OUT + N_RKV : N_IN + N_OUT + N_RKV + N_O))));
    const int per = cat == 0 ? IT_IN : (cat == 1 ? IT_OUT : (cat == 4 ? IT_GLU : IT_SQ));
    const int mi = r0 / per, r = r0 - mi * per;
    const int ldw = cat == 0 ? 2 * FF : (cat == 4 ? 2 * D : D), K = cat == 1 ? FF : D, nblk = ldw / 32, kb = r / nblk, nb = r - kb * nblk, n0 = 32 * nb;
    const int split = cat == 0 ? FF : D, hs = n0 >= split ? 1 : 0, jj = n0 - hs * split;
    const int drow0 = (cat == 0 || cat == 4) ? (jj >> 7) * 256 + hs * 128 + (jj & 127) : n0;
    const float* sb = cat == 0 ? a.in[I_FFN_WIN] : (cat == 1 ? a.in[I_FFN_WOUT] : (cat == 2 ? a.in[I_WRKV] : (cat == 3 ? a.in[I_WO] : a.in[I_WGLU])));
    const size_t woff = cat == 0 ? WS_WIN : (cat == 1 ? WS_WOUT : (cat == 2 ? WS_WRKV : (cat == 3 ? WS_WO : WS_WGLU)));
    const size_t msz = (size_t)ldw * K;
    TrDesc d;
    d.src = sb + (size_t)mi * msz + (size_t)(64 * kb) * ldw + n0; d.ldw = ldw; d.K = K;
    d.dst = (bf16*)(ws + woff) + (size_t)mi * msz + (size_t)drow0 * K + 64 * kb;
    d.scale = cat == 0 ? a.in[I_FFN_NORM] + (size_t)mi * D + 64 * kb : nullptr;
    return d;
}
__device__ __forceinline__ void tr_load(const TrDesc& d, int lane, float (&v)[32]) {
    const float* p = d.src + (size_t)(lane >> 5) * d.ldw + (lane & 31);
#pragma unroll
    for (int i = 0; i < 32; ++i) v[i] = __builtin_nontemporal_load(p + (size_t)(2 * i) * d.ldw);
}
__device__ __forceinline__ void tr_store(const TrDesc& d, int lane, LAS float* scr, const float (&v)[32]) {
#pragma unroll
    for (int i = 0; i < 32; ++i) scr[(2 * i + (lane >> 5)) * 33 + (lane & 31)] = v[i];
    LDS_WAIT(); asm volatile("" ::: "memory");
    const int c = lane & 7;
    f32x4 s0 = (f32x4){1.f, 1.f, 1.f, 1.f}, s1 = s0;
    if (d.scale) { s0 = ld4(d.scale + 8 * c); s1 = ld4(d.scale + 8 * c + 4); }
#pragma unroll
    for (int j = 0; j < 4; ++j) { const int n = (lane >> 3) + 8 * j; const LAS float* s = scr + (8 * c) * 33 + n;
        v4u o; o.x = pk2(s[0 * 33] * s0[0], s[1 * 33] * s0[1]); o.y = pk2(s[2 * 33] * s0[2], s[3 * 33] * s0[3]); o.z = pk2(s[4 * 33] * s1[0], s[5 * 33] * s1[1]); o.w = pk2(s[6 * 33] * s1[2], s[7 * 33] * s1[3]);
        __builtin_nontemporal_store(o, (v4u*)(d.dst + (size_t)n * d.K + 8 * c)); }
    LDS_WAIT(); asm volatile("" ::: "memory");
}
__device__ __forceinline__ int conv_set_count(int set) {
    constexpr int IT_IN = (D / 64) * (2 * FF / 32), IT_OUT = (FF / 64) * (D / 32), IT_SQ = (D / 64) * (D / 32), IT_GLU = (D / 64) * (2 * D / 32);
    return (set == 0 || set == 2) ? 2 * IT_IN + 2 * IT_OUT + 4 * IT_SQ : 2 * IT_IN + 2 * IT_OUT + IT_GLU;
}
__device__ __forceinline__ int conv_set_item(int set, int idx) {
    constexpr int IT_IN = (D / 64) * (2 * FF / 32), IT_OUT = (FF / 64) * (D / 32), IT_SQ = (D / 64) * (D / 32), IT_GLU = (D / 64) * (2 * D / 32);
    constexpr int B_IN = 0, B_OUT = 8 * IT_IN, B_RKV = B_OUT + 8 * IT_OUT, B_O = B_RKV + 6 * IT_SQ, B_GLU = B_O + 2 * IT_SQ;
    const int in_lo = 2 * set;
    const bool rw = (set & 1) == 0;
    int r = idx;
    if (r < 2 * IT_IN) return B_IN + in_lo * IT_IN + r;
    r -= 2 * IT_IN;
    if (r < 2 * IT_OUT) return B_OUT + in_lo * IT_OUT + r;
    r -= 2 * IT_OUT;
    if (rw) { if (r < 3 * IT_SQ) return B_RKV + 3 * (set >> 1) * IT_SQ + r; r -= 3 * IT_SQ; return B_O + (set >> 1) * IT_SQ + r; }
    return B_GLU + (set >> 1) * IT_GLU + r;
}
__device__ __forceinline__ void convert_set(const Args& a, int lane, LAS float* scr, int set, int wave_id, int nwaves) {
    const int n = conv_set_count(set);
    int it = wave_id; TrDesc d, dn; float v[32], vn[32];
    bool has = it < n;
    if (has) { d = tr_decode(a, conv_set_item(set, it)); tr_load(d, lane, v); }
    while (has) {
        const int nx = it + nwaves; const bool hn = nx < n;
        if (hn) { dn = tr_decode(a, conv_set_item(set, nx)); tr_load(dn, lane, vn); }
        tr_store(d, lane, scr, v);
        d = dn; it = nx; has = hn;
#pragma unroll
        for (int i = 0; i < 32; ++i) v[i] = vn[i];
    }
}
__device__ __forceinline__ void p0_prologue(const Args& a, Frame& F) {
    unsigned char* ws = a.ws;
    convert_set(a, F.lane, (LAS float*)(F.lds + F.wave * 16384), 0, F.gw, F.NGW);
    if (F.G <= BATCH * NH) { convert_set(a, F.lane, (LAS float*)(F.lds + F.wave * 16384), 1, F.gw, F.NGW); convert_set(a, F.lane, (LAS float*)(F.lds + F.wave * 16384), 2, F.gw, F.NGW); convert_set(a, F.lane, (LAS float*)(F.lds + F.wave * 16384), 3, F.gw, F.NGW); }
    const int gt = F.gw * 64 + F.lane, NGT = F.NGW * 64;
    for (int idx = gt; idx < 2 * 1024 * D; idx += NGT) {
        const int j = idx / (1024 * D), rem = idx % (1024 * D), n = rem / D, k = rem % D, half = n >> 9, nn = n & 511;
        float v = 0.f; const float* src = nullptr; int rank = 0, off = 0, murow = 0;
        if (nn < 128) { src = a.in[I_WL1] + (size_t)j * D * WL; rank = WL; off = 0; murow = 3; }
        else if (nn < 256) { src = a.in[I_AL1] + (size_t)j * D * AL; rank = AL; off = 128; murow = 4; }
        else if (nn < 352) { src = a.in[I_GL1] + (size_t)j * D * GL; rank = GL; off = 256; murow = 5; }
        else if (nn < 448 && j >= 1) { src = a.in[I_VL1] + (size_t)(j - 1) * D * VL; rank = VL; off = 352; murow = 2; }
        if (src) { const float mu = a.in[I_MU][(size_t)(j * 6 + murow) * D + k]; v = src[(size_t)k * rank + (nn - off)] * (half ? mu : 1.0f - mu); }
        ((bf16*)(ws + WS_WL1))[idx] = (bf16)(pk2(v, 0.f) & 0xffffu);
    }
    for (int idx = gt; idx < 2 * 4 * 128 * D; idx += NGT) {
        const int j = idx / (4 * 128 * D), rem = idx % (4 * 128 * D), c = rem / (128 * D), rem2 = rem % (128 * D), n = rem2 / 128, k = rem2 % 128;
        float v = 0.f;
        if (c == 0) { if (k < WL) v = a.in[I_WL2][((size_t)j * WL + k) * D + n]; }
        else if (c == 1) { if (k < AL) v = a.in[I_AL2][((size_t)j * AL + k) * D + n]; }
        else if (c == 2) { if (k < GL) v = a.in[I_GL2][((size_t)j * GL + k) * D + n]; }
        else { if (k < VL && j >= 1) v = a.in[I_VL2][((size_t)(j - 1) * VL + k) * D + n]; }
        ((bf16*)(ws + WS_WL2))[((size_t)(j * 4 + c) * D + n) * 128 + k] = (bf16)(pk2(v, 0.f) & 0xffffu);
    }
    for (int idx = gt; idx < 2 * 4 * D; idx += NGT) {
        const int j = idx / (4 * D), c = (idx / D) & 3, n = idx % D; float v = 0.f;
        if (c == 0) v = a.in[I_W0][j * D + n]; else if (c == 1) v = a.in[I_A0][j * D + n]; else if (c == 3 && j >= 1) v = a.in[I_V0][(j - 1) * D + n];
        ((float*)(ws + WS_BIAS))[idx] = v;
    }
    for (int row = F.gw; row < M; row += F.NGW) {
        const float* xr = a.in[I_X] + (size_t)row * D + 4 * F.lane; bf16* xb = (bf16*)(ws + WS_XB) + (size_t)row * D + 4 * F.lane; float ss = 0.f;
#pragma unroll 4
        for (int q = 0; q < 16; ++q) { const f32x4 v = __builtin_nontemporal_load((const f32x4*)(xr + 256 * q)); ss += sq4(v); v2u w; w.x = pk2(v[0], v[1]); w.y = pk2(v[2], v[3]); *(v2u*)(xb + 256 * q) = w; }
        ((float*)(ws + WS_SSP))[(size_t)row * SSPW + F.lane] = ss;
    }
}

__device__ __forceinline__ void rwkv_prep(const Args& a, Frame& F, int j, int li) {
    const bf16* X = (const bf16*)(a.ws + WS_XB); const float* ssp = (const float*)(a.ws + WS_SSP); const float* gm = a.in[I_MIX_NORM] + (size_t)li * D; const float* mu = a.in[I_MU] + (size_t)j * 6 * D;
    bf16* XR = (bf16*)(a.ws + WS_XR); bf16* XK = XR + (size_t)M * D; bf16* XV = XK + (size_t)M * D; bf16* HB = (bf16*)(a.ws + WS_HB);
    for (int run = F.gw; run < M / 8; run += F.NGW) {
        const int row0 = run * 8; const bool first = (row0 % T) == 0;
        float rs[9];
#pragma unroll
        for (int r = 0; r < 9; ++r) { const int row = row0 - 1 + r; float s = (r == 0 && first) ? 1.f : ssp[(size_t)row * SSPW + F.lane]; s = wave_sum(s); rs[r] = __builtin_amdgcn_rsqf(s * (1.0f / D) + RMS_EPS); }
        for (int q = 0; q < 16; ++q) {
            const int col = 256 * q + 4 * F.lane;
            const f32x4 g4 = ld4(gm + col), mr = ld4(mu + col), mk = ld4(mu + D + col), mv = ld4(mu + 2 * D + col);
            f32x4 hp = (f32x4){0.f, 0.f, 0.f, 0.f};
            if (!first) hp = ldb4(X + (size_t)(row0 - 1) * D + col) * rs[0] * g4;
#pragma unroll
            for (int r = 0; r < 8; ++r) { const size_t o = (size_t)(row0 + r) * D + col;
                const f32x4 h = ldb4(X + o) * rs[r + 1] * g4, dx = hp - h, xr = h + dx * mr, xk = h + dx * mk, xv = h + dx * mv;
                v2u w; w.x = pk2(xr[0], xr[1]); w.y = pk2(xr[2], xr[3]); *(v2u*)(XR + o) = w;
                w.x = pk2(xk[0], xk[1]); w.y = pk2(xk[2], xk[3]); *(v2u*)(XK + o) = w;
                w.x = pk2(xv[0], xv[1]); w.y = pk2(xv[2], xv[3]); *(v2u*)(XV + o) = w;
                w.x = pk2(h[0], h[1]); w.y = pk2(h[2], h[3]); *(v2u*)(HB + o) = w;
                hp = h; }
        }
    }
}
__device__ __forceinline__ void rwkv_mid(const Args& a, Frame& F, int j) {
    const float* Z = (const float*)(a.ws + WS_Z); bf16* MID = (bf16*)(a.ws + WS_MID);
    const int gt = F.gw * 64 + F.lane, NGT = F.NGW * 64, nz = j ? 4 : 3;
    for (int idx = gt; idx < nz * M * 16; idx += NGT) {
        const int z = idx / (M * 16), rem = idx % (M * 16), t = rem >> 4, k8 = (rem & 15) * 8;
        const int rank = z < 2 ? 128 : 96, off = z == 0 ? 0 : (z == 1 ? 128 : (z == 2 ? 256 : 352));
        v4u w = (v4u){0u, 0u, 0u, 0u};
        if (k8 < rank) {
            const float* za = Z + (size_t)t * 1024 + off + k8; f32x4 v0 = ld4(za), v1 = ld4(za + 4);
            if ((t % T) != 0) { const float* zb = Z + (size_t)(t - 1) * 1024 + 512 + off + k8; v0 = v0 + ld4(zb); v1 = v1 + ld4(zb + 4); }
            if (z == 0) {
#pragma unroll
                for (int e = 0; e < 4; ++e) { v0[e] = tanhf(v0[e]); v1[e] = tanhf(v1[e]); } }
            else if (z == 2) {
#pragma unroll
                for (int e = 0; e < 4; ++e) { v0[e] = sigmoid_p(v0[e]); v1[e] = sigmoid_p(v1[e]); } }
            w.x = pk2(v0[0], v0[1]); w.y = pk2(v0[2], v0[3]); w.z = pk2(v1[0], v1[1]); w.w = pk2(v1[2], v1[3]);
        }
        *(v4u*)(MID + ((size_t)z * M + t) * 128 + k8) = w;
    }
}
__device__ __forceinline__ void rwkv_rec(const Args& a, Frame& F, int j) {
    for (int item = blockIdx.x; item < BATCH * NH; item += F.G) {
    const int b = item / NH, h = item % NH, tid = F.tid;
    LAS float* L = (LAS float*)F.lds;
    LAS float *sKK = L, *sW = L + 2048, *sB = L + 4096, *sKP = L + 6144, *sR = L + 8192, *sV = L + 10240, *sY = L + 12288, *sBon = L + 14336;
    const int tt = tid >> 4, cq = tid & 15, col = h * 64 + 4 * cq;
    const f32x4 kk4 = ld4(a.in[I_KK] + (size_t)j * D + col), ka4 = ld4(a.in[I_KA] + (size_t)j * D + col), rk4 = ld4(a.in[I_RK] + (size_t)j * D + col),
                lnw4 = ld4(a.in[I_LNW] + (size_t)j * D + col), lnb4 = ld4(a.in[I_LNB] + (size_t)j * D + col);
    const float* Rp = (const float*)(a.ws + WS_R); const float* Kp = (const float*)(a.ws + WS_K); const float* Vp = (const float*)(a.ws + (j ? WS_V1 : WS_V0)); const float* VF = (const float*)(a.ws + WS_V0);
    const float* WP = (const float*)(a.ws + WS_LO); const float* AP = WP + (size_t)M * D; const float* GP = AP + (size_t)M * D; const float* VG = GP + (size_t)M * D;
    bf16* YG = (bf16*)(a.ws + WS_YG);
    const int vl = F.lane >> 3, kq = F.lane & 7, vrow = 8 * F.wave + vl;
    float S[8];
#pragma unroll
    for (int e = 0; e < 8; ++e) S[e] = 0.f;
    size_t base = ((size_t)(b * T + tt)) * D + col;
    f32x4 r4 = ld4(Rp + base), k4 = ld4(Kp + base), v4 = ld4(Vp + base), wp4 = ld4(WP + base), ap4 = ld4(AP + base), g4 = ld4(GP + base);
    f32x4 vg4 = (f32x4){0.f, 0.f, 0.f, 0.f}, vf4 = vg4;
    if (j) { vg4 = ld4(VG + base); vf4 = ld4(VF + base); }
    for (int c = 0; c < T / 32; ++c) {
        f32x4 aa, ww, vv, kk, kp, bb; float ss = 0.f, bon = 0.f;
#pragma unroll
        for (int e = 0; e < 4; ++e) {
            aa[e] = sigmoid_p(ap4[e]);
            const float zz = -wp4[e], sp = fmaxf(zz, 0.f) + log1pf(expf(-fabsf(zz)));
            ww[e] = expf(-expf(-sp - 0.5f));
            vv[e] = j ? v4[e] + (vf4[e] - v4[e]) * sigmoid_p(vg4[e]) : v4[e];
            kk[e] = k4[e] * kk4[e]; kp[e] = k4[e] * (1.0f + (aa[e] - 1.0f) * ka4[e]);
            ss += kk[e] * kk[e]; bon += r4[e] * kp[e] * rk4[e];
        }
        ss = sum16(ss); bon = sum16(bon);
        const float inv = 1.0f / fmaxf(sqrtf(ss), 1e-12f);
        kk = kk * inv; bb = kk * aa;
        const f32x4 gcur = g4;
        *(LAS f32x4*)(sKK + tt * 64 + 4 * cq) = kk; *(LAS f32x4*)(sW + tt * 64 + 4 * cq) = ww; *(LAS f32x4*)(sB + tt * 64 + 4 * cq) = bb;
        *(LAS f32x4*)(sKP + tt * 64 + 4 * cq) = kp; *(LAS f32x4*)(sR + tt * 64 + 4 * cq) = r4; *(LAS f32x4*)(sV + tt * 64 + 4 * cq) = vv;
        if (cq == 0) sBon[tt] = bon;
        if (c + 1 < T / 32) { base += (size_t)32 * D;
            r4 = ld4(Rp + base); k4 = ld4(Kp + base); v4 = ld4(Vp + base); wp4 = ld4(WP + base); ap4 = ld4(AP + base); g4 = ld4(GP + base);
            if (j) { vg4 = ld4(VG + base); vf4 = ld4(VF + base); } }
        __syncthreads();
#pragma unroll 2
        for (int t2 = 0; t2 < 32; ++t2) {
            const int o = t2 * 64 + 8 * kq;
            const f32x4 ka = *(const LAS f32x4*)(sKK + o), kb = *(const LAS f32x4*)(sKK + o + 4), wa = *(const LAS f32x4*)(sW + o), wb = *(const LAS f32x4*)(sW + o + 4),
                        ba = *(const LAS f32x4*)(sB + o), bb2 = *(const LAS f32x4*)(sB + o + 4), pa = *(const LAS f32x4*)(sKP + o), pb = *(const LAS f32x4*)(sKP + o + 4),
                        ra = *(const LAS f32x4*)(sR + o), rb = *(const LAS f32x4*)(sR + o + 4);
            const float vval = sV[t2 * 64 + vrow];
            float p = 0.f;
#pragma unroll
            for (int e = 0; e < 4; ++e) { p += S[e] * ka[e]; p += S[4 + e] * kb[e]; }
            p = sum8_dpp(p);
            float y = 0.f;
#pragma unroll
            for (int e = 0; e < 4; ++e) {
                S[e] = S[e] * wa[e] + (vval * pa[e] - p * ba[e]); S[4 + e] = S[4 + e] * wb[e] + (vval * pb[e] - p * bb2[e]);
                y += S[e] * ra[e]; y += S[4 + e] * rb[e]; }
            y = sum8_dpp(y);
            if (kq == 0) sY[t2 * 64 + vrow] = y;
        }
        __syncthreads();
        {
            const f32x4 y4 = *(const LAS f32x4*)(sY + tt * 64 + 4 * cq), vv4 = *(const LAS f32x4*)(sV + tt * 64 + 4 * cq); const float bo = sBon[tt];
            const float mean = sum16(sum4(y4)) * (1.0f / 64.0f); const f32x4 d = y4 - mean; const float var = sum16(sq4(d)) * (1.0f / 64.0f); const float rstd = 1.0f / sqrtf(var + GN_EPS);
            f32x4 o4;
#pragma unroll
            for (int e = 0; e < 4; ++e) o4[e] = (d[e] * rstd * lnw4[e] + lnb4[e] + bo * vv4[e]) * gcur[e];
            v2u w; w.x = pk2(o4[0], o4[1]); w.y = pk2(o4[2], o4[3]);
            *(v2u*)(YG + ((size_t)(b * T + c * 32 + tt)) * D + col) = w;
        }
        __syncthreads();
    }
    }
}

__device__ __forceinline__ float wave_sum_dpp(float x) {
    x += __builtin_bit_cast(float, __builtin_amdgcn_update_dpp(0, __builtin_bit_cast(int, x), 0xB1, 0xF, 0xF, true));
    x += __builtin_bit_cast(float, __builtin_amdgcn_update_dpp(0, __builtin_bit_cast(int, x), 0x4E, 0xF, 0xF, true));
    x += __builtin_bit_cast(float, __builtin_amdgcn_update_dpp(0, __builtin_bit_cast(int, x), 0x141, 0xF, 0xF, true));
    x += __builtin_bit_cast(float, __builtin_amdgcn_update_dpp(0, __builtin_bit_cast(int, x), 0x140, 0xF, 0xF, true));
    const int xi = __builtin_bit_cast(int, x);
    return (__builtin_bit_cast(float, __builtin_amdgcn_readlane(xi, 0)) + __builtin_bit_cast(float, __builtin_amdgcn_readlane(xi, 16))) +
           (__builtin_bit_cast(float, __builtin_amdgcn_readlane(xi, 32)) + __builtin_bit_cast(float, __builtin_amdgcn_readlane(xi, 48)));
}
__device__ __forceinline__ bf16 bf1(float x) { return (bf16)(pk2(x, x) & 0xffffu); }
__device__ __forceinline__ float fexp(float x) { return __builtin_amdgcn_exp2f(x * 1.44269504f); }
__device__ __forceinline__ float fsigm(float x) { return __builtin_amdgcn_rcpf(1.0f + __builtin_amdgcn_exp2f(-1.44269504f * x)); }
__device__ __forceinline__ float flog(float x) { return __builtin_amdgcn_logf(x) * 0.69314718f; }
__device__ __forceinline__ void rwkv_rec2(const Args& a, Frame& F, int j) {
    constexpr int CL = 32, NCH = T / CL, P64 = 144, P32 = 80;
    constexpr int O_AT = 0, O_BT = O_AT + 32 * P64, O_KT = O_BT + 32 * P64, O_RT = O_KT + 32 * P64, O_BGT = O_RT + 32 * P64, O_KGT = O_BGT + 64 * P32, O_VT = O_KGT + 64 * P32,
                  O_WT = O_VT + 64 * P32, O_UT = O_WT + 64 * P32, O_S = O_UT + 64 * P32, O_MAB = O_S + 64 * P64, O_T = O_MAB + 4096, O_MAK = O_T + 32 * P32, O_MRB = O_MAK + 32 * P32,
                  O_MRK = O_MRB + 32 * P32, O_YL = O_MRK + 32 * P32, O_TOT = O_YL + 8192, O_GL = O_TOT + 2048, O_END = O_GL + 256;
    static_assert(O_END <= RING_BYTES, "rec2 LDS map");
    for (int item = blockIdx.x; item < BATCH * NH; item += F.G) {
    const int b = item / NH, h = item % NH, lane = F.lane, w = F.wave, r = lane & 31, hh = lane >> 5;
    LAS unsigned char* L = F.lds;
    const int col = h * 64 + lane;
    const float kkc = a.in[I_KK][(size_t)j * D + col], kac = a.in[I_KA][(size_t)j * D + col], rkc = a.in[I_RK][(size_t)j * D + col], lnw = a.in[I_LNW][(size_t)j * D + col], lnb = a.in[I_LNB][(size_t)j * D + col];
    const float* Rp = (const float*)(a.ws + WS_R); const float* Kp = (const float*)(a.ws + WS_K); const float* Vp = (const float*)(a.ws + (j ? WS_V1 : WS_V0)); const float* VF = (const float*)(a.ws + WS_V0);
    const float* WP = (const float*)(a.ws + WS_LO); const float* AP = WP + (size_t)M * D; const float* GP = AP + (size_t)M * D; const float* VG = GP + (size_t)M * D;
    bf16* YG = (bf16*)(a.ws + WS_YG);
    for (int i = F.tid; i < 64 * P64 / 4; i += NWAVES * 64) ((LAS unsigned*)(L + O_S))[i] = 0u;
    f32x16 accS;
#pragma unroll
    for (int i = 0; i < 16; ++i) accS[i] = 0.f;
    float pr[4], pk[4], pv[4], pw[4], pa[4], pg[4], pvg[4], pvf[4];
    size_t base = ((size_t)(b * T + 4 * w)) * D + col;
#pragma unroll
    for (int i = 0; i < 4; ++i) { const size_t o = base + (size_t)i * D; pr[i] = Rp[o]; pk[i] = Kp[o]; pv[i] = Vp[o]; pw[i] = WP[o]; pa[i] = AP[o]; pg[i] = GP[o]; pvg[i] = j ? VG[o] : 0.f; pvf[i] = j ? VF[o] : 0.f; }
    __syncthreads();
#define RFRAG(ob, row, pitch, q) (*(const LAS bf16x8*)(L + (ob) + (row) * (pitch) + (16 * (q) + 8 * hh) * 2))
    for (int c = 0; c < NCH; ++c) {
        float aa[4], lw[4], vv[4], kkn[4], kp[4], bon[4], rr[4], gg[4], cum[4];
#pragma unroll
        for (int i = 0; i < 4; ++i) {
            aa[i] = fsigm(pa[i]);
            const float zz = -pw[i], sp = fmaxf(zz, 0.f) + flog(1.0f + fexp(-fabsf(zz)));
            lw[i] = -fexp(-sp - 0.5f);
            vv[i] = j ? pv[i] + (pvf[i] - pv[i]) * fsigm(pvg[i]) : pv[i];
            const float kk = pk[i] * kkc; const float ss = wave_sum_dpp(kk * kk);
            kkn[i] = kk * __builtin_amdgcn_rsqf(fmaxf(ss, 1e-24f));
            kp[i] = pk[i] * (1.0f + (aa[i] - 1.0f) * kac);
            bon[i] = wave_sum_dpp(pr[i] * kp[i] * rkc); rr[i] = pr[i]; gg[i] = pg[i];
        }
        cum[0] = lw[0]; cum[1] = cum[0] + lw[1]; cum[2] = cum[1] + lw[2]; cum[3] = cum[2] + lw[3];
        ((LAS float*)(L + O_TOT))[w * 64 + lane] = cum[3];
        if (c + 1 < NCH) { base += (size_t)CL * D;
#pragma unroll
            for (int i = 0; i < 4; ++i) { const size_t o = base + (size_t)i * D; pr[i] = Rp[o]; pk[i] = Kp[o]; pv[i] = Vp[o]; pw[i] = WP[o]; pa[i] = AP[o]; pg[i] = GP[o]; if (j) { pvg[i] = VG[o]; pvf[i] = VF[o]; } } }
        __syncthreads();
        {
            float off = 0.f, tot = 0.f;
#pragma unroll
            for (int ww = 0; ww < 8; ++ww) { const float tv = ((const LAS float*)(L + O_TOT))[ww * 64 + lane]; tot += tv; if (ww < w) off += tv; }
            unsigned bgp[2], kgp[2], vtp[2]; float bgv[4], kgv[4];
#pragma unroll
            for (int i = 0; i < 4; ++i) { const int t = 4 * w + i; const float cm = off + cum[i];
                const float gam = fexp(cm), gprev = fexp(cm - lw[i]), ginv = fexp(-cm), gl = fexp(tot - cm);
                *(LAS bf16*)(L + O_AT + t * P64 + lane * 2) = bf1(-kkn[i] * gprev);
                *(LAS bf16*)(L + O_BT + t * P64 + lane * 2) = bf1(kkn[i] * aa[i] * ginv);
                *(LAS bf16*)(L + O_KT + t * P64 + lane * 2) = bf1(kp[i] * ginv);
                *(LAS bf16*)(L + O_RT + t * P64 + lane * 2) = bf1(rr[i] * gam);
                bgv[i] = kkn[i] * aa[i] * gl; kgv[i] = kp[i] * gl; }
            bgp[0] = pk2(bgv[0], bgv[1]); bgp[1] = pk2(bgv[2], bgv[3]); kgp[0] = pk2(kgv[0], kgv[1]); kgp[1] = pk2(kgv[2], kgv[3]); vtp[0] = pk2(vv[0], vv[1]); vtp[1] = pk2(vv[2], vv[3]);
            *(LAS v2u*)(L + O_BGT + lane * P32 + 8 * w) = (v2u){bgp[0], bgp[1]};
            *(LAS v2u*)(L + O_KGT + lane * P32 + 8 * w) = (v2u){kgp[0], kgp[1]};
            *(LAS v2u*)(L + O_VT + lane * P32 + 8 * w) = (v2u){vtp[0], vtp[1]};
            if (w == 0) ((LAS float*)(L + O_GL))[lane] = fexp(tot);
        }
        __syncthreads();
        f32x16 accWY;
#pragma unroll
        for (int i = 0; i < 16; ++i) accWY[i] = 0.f;
        const int vh = w & 1;
        if (w < 4) {
            const int oa = (w < 2) ? O_AT : O_RT, ob = (w & 1) ? O_KT : O_BT;
#pragma unroll
            for (int q = 0; q < 4; ++q) accWY = __builtin_amdgcn_mfma_f32_32x32x16_bf16(RFRAG(oa, r, P64, q), RFRAG(ob, r, P64, q), accWY, 0, 0, 0);
            const int om = (w == 1) ? O_MAK : ((w == 2) ? O_MRB : O_MRK);
#pragma unroll
            for (int i = 0; i < 16; ++i) { const int t = (i & 3) + 8 * (i >> 2) + 4 * hh; const bool keep = (w < 2) ? (r < t) : (r <= t); const float val = keep ? accWY[i] : 0.f;
                if (w == 0) ((LAS float*)(L + O_MAB))[t * 32 + r] = val; else *(LAS bf16*)(L + om + t * P32 + r * 2) = bf1(val); }
        } else {
            const int oa = (w < 6) ? O_AT : O_RT;
#pragma unroll
            for (int q = 0; q < 4; ++q) accWY = __builtin_amdgcn_mfma_f32_32x32x16_bf16(RFRAG(oa, r, P64, q), RFRAG(O_S, 32 * vh + r, P64, q), accWY, 0, 0, 0);
        }
        __syncthreads();
        if (w == 0) {
            LAS float* TL = (LAS float*)(L + O_YL); const LAS float* MB = (const LAS float*)(L + O_MAB);
#pragma unroll 1
            for (int rb = 0; rb < 4; ++rb) {
                float acc[8];
#pragma unroll
                for (int e = 0; e < 8; ++e) acc[e] = (8 * rb + e == r) ? 1.f : 0.f;
#pragma unroll 1
                for (int s4 = 0; s4 < 2 * rb; ++s4) {
                    const float t0 = TL[(4 * s4 + 0) * 32 + r], t1 = TL[(4 * s4 + 1) * 32 + r], t2 = TL[(4 * s4 + 2) * 32 + r], t3 = TL[(4 * s4 + 3) * 32 + r];
#pragma unroll
                    for (int e = 0; e < 8; ++e) { const f32x4 m = *(const LAS f32x4*)(MB + (8 * rb + e) * 32 + 4 * s4); acc[e] += (m[0] * t0 + m[1] * t1) + (m[2] * t2 + m[3] * t3); }
                }
#pragma unroll
                for (int e = 1; e < 8; ++e) { const f32x4 m0 = *(const LAS f32x4*)(MB + (8 * rb + e) * 32 + 8 * rb), m1 = *(const LAS f32x4*)(MB + (8 * rb + e) * 32 + 8 * rb + 4);
#pragma unroll
                    for (int e2 = 0; e2 < e; ++e2) acc[e] += (e2 < 4 ? m0[e2 & 3] : m1[e2 & 3]) * acc[e2]; }
                if (hh == 0) {
#pragma unroll
                    for (int e = 0; e < 8; ++e) { TL[(8 * rb + e) * 32 + r] = acc[e]; *(LAS bf16*)(L + O_T + (8 * rb + e) * P32 + r * 2) = bf1(acc[e]); } }
                LDS_WAIT();
            }
        } else if (w >= 4) {
            const int om = (w < 6) ? O_MAK : O_MRK;
#pragma unroll
            for (int q = 0; q < 2; ++q) accWY = __builtin_amdgcn_mfma_f32_32x32x16_bf16(RFRAG(om, r, P32, q), RFRAG(O_VT, 32 * vh + r, P32, q), accWY, 0, 0, 0);
            if (w < 6) {
#pragma unroll
                for (int g = 0; g < 4; ++g) *(LAS v2u*)(L + O_WT + (32 * vh + r) * P32 + (8 * g + 4 * hh) * 2) = (v2u){pk2(accWY[4 * g], accWY[4 * g + 1]), pk2(accWY[4 * g + 2], accWY[4 * g + 3])}; }
        }
        __syncthreads();
        if (w == 4 || w == 5) {
            f32x16 accU;
#pragma unroll
            for (int i = 0; i < 16; ++i) accU[i] = 0.f;
#pragma unroll
            for (int q = 0; q < 2; ++q) accU = __builtin_amdgcn_mfma_f32_32x32x16_bf16(RFRAG(O_T, r, P32, q), RFRAG(O_WT, 32 * vh + r, P32, q), accU, 0, 0, 0);
#pragma unroll
            for (int g = 0; g < 4; ++g) *(LAS v2u*)(L + O_UT + (32 * vh + r) * P32 + (8 * g + 4 * hh) * 2) = (v2u){pk2(accU[4 * g], accU[4 * g + 1]), pk2(accU[4 * g + 2], accU[4 * g + 3])};
        }
        __syncthreads();
        if (w < 4) {
            const int kh = w >> 1;
#pragma unroll
            for (int i = 0; i < 16; ++i) accS[i] *= ((const LAS float*)(L + O_GL))[32 * kh + (i & 3) + 8 * (i >> 2) + 4 * hh];
#pragma unroll
            for (int q = 0; q < 2; ++q) { accS = __builtin_amdgcn_mfma_f32_32x32x16_bf16(RFRAG(O_BGT, 32 * kh + r, P32, q), RFRAG(O_UT, 32 * vh + r, P32, q), accS, 0, 0, 0);
                                          accS = __builtin_amdgcn_mfma_f32_32x32x16_bf16(RFRAG(O_KGT, 32 * kh + r, P32, q), RFRAG(O_VT, 32 * vh + r, P32, q), accS, 0, 0, 0); }
#pragma unroll
            for (int g = 0; g < 4; ++g) *(LAS v2u*)(L + O_S + (32 * vh + r) * P64 + (32 * kh + 8 * g + 4 * hh) * 2) = (v2u){pk2(accS[4 * g], accS[4 * g + 1]), pk2(accS[4 * g + 2], accS[4 * g + 3])};
        } else if (w >= 6) {
#pragma unroll
            for (int q = 0; q < 2; ++q) accWY = __builtin_amdgcn_mfma_f32_32x32x16_bf16(RFRAG(O_MRB, r, P32, q), RFRAG(O_UT, 32 * vh + r, P32, q), accWY, 0, 0, 0);
#pragma unroll
            for (int i = 0; i < 16; ++i) ((LAS float*)(L + O_YL))[((i & 3) + 8 * (i >> 2) + 4 * hh) * 64 + 32 * vh + r] = accWY[i];
        }
        __syncthreads();
#pragma unroll
        for (int i = 0; i < 4; ++i) { const int t = 4 * w + i; const float y = ((const LAS float*)(L + O_YL))[t * 64 + lane];
            const float mean = wave_sum_dpp(y) * (1.0f / 64.0f), d = y - mean, var = wave_sum_dpp(d * d) * (1.0f / 64.0f);
            const float o = (d * __builtin_amdgcn_rsqf(var + GN_EPS) * lnw + lnb + bon[i] * vv[i]) * gg[i];
            YG[((size_t)(b * T + c * CL + t)) * D + col] = bf1(o); }
    }
#undef RFRAG
    __syncthreads();
    }
}

namespace rc {
constexpr int CL = 32, NCH = T / CL, P64 = 144, P32 = 80;
constexpr int IM_AT = 0, IM_RT = IM_AT + 32 * P64, IM_BGT = IM_RT + 32 * P64, IM_KGT = IM_BGT + 64 * P32, IM_VT = IM_KGT + 64 * P32, IM_T = IM_VT + 64 * P32, IM_MAK = IM_T + 32 * P32,
              IM_MRB = IM_MAK + 32 * P32, IM_MRK = IM_MRB + 32 * P32, IM_GL = IM_MRK + 32 * P32, IM_BON = IM_GL + 256, IMG_BYTES = IM_BON + 128;
constexpr int IMG_PIECES = IMG_BYTES / 16, T_PIECE0 = IM_T / 16, T_PIECES = 32 * P32 / 16;
static_assert(IMG_BYTES % 16 == 0 && IM_T % 16 == 0, "image pieces");
constexpr int PO_BT = IMG_BYTES, PO_KT = PO_BT + 32 * P64, PO_MAB = PO_KT + 32 * P64, PO_TL = PO_MAB + 4096, PO_TOT = PO_TL + 4096, PO_END = PO_TOT + 2048;
constexpr int CO_WT = IMG_BYTES, CO_UT = CO_WT + 64 * P32, CO_S = CO_UT + 64 * P32, CO_YL = CO_S + 64 * P64, CO_END = CO_YL + 8192;
static_assert(PO_END <= RING_BYTES && CO_END <= RING_BYTES, "rec LDS maps");
}
__device__ __forceinline__ void rec_prep(const Args& a, Frame& F, int j) {
    using namespace rc;
    constexpr int US = PO_END;
    static_assert(2 * US <= RING_BYTES && NCH % 2 == 0, "rec_prep LDS map (two chunks)");
    const int lane = F.lane, w = F.wave, r = lane & 31, hh = lane >> 5;
    LAS unsigned char* L = F.lds;
    const bf16* Rp = (const bf16*)(a.ws + WS_R); const bf16* Kp = (const bf16*)(a.ws + WS_K); const bf16* Vp = (const bf16*)(a.ws + (j ? WS_V1 : WS_V0)); const bf16* VF = (const bf16*)(a.ws + WS_V0);
    const bf16* WP = (const bf16*)(a.ws + WS_LO); const bf16* AP = WP + (size_t)M * D; const bf16* GP = AP + (size_t)M * D; const bf16* VG = GP + (size_t)M * D;
    unsigned char* IMG = a.ws + WS_IMG;
    constexpr int NPAIR = BATCH * NH * NCH / 2;
    static_assert(2 * US + NWAVES * 2048 <= RING_BYTES, "rec_prep staging buffers");
    v4u rwR, rwK, rwV, rwW, rwA, rwG = (v4u){0u, 0u, 0u, 0u}, rwF = (v4u){0u, 0u, 0u, 0u};
    const int lrow = lane >> 3, lseg = lane & 7;
#define BF2F(x) __uint_as_float((unsigned)(x) << 16)
#define WBASE(pair_) (((size_t)(((2 * (pair_)) / NCH / NH) * T + ((2 * (pair_)) % NCH + (lrow >> 2)) * CL + 4 * w + (lrow & 3))) * D + (((2 * (pair_)) / NCH) % NH) * 64 + 8 * lseg)
#define WLD(P, o) __builtin_nontemporal_load((const v4u*)((P) + (o)))
    int pair = blockIdx.x;
    if (pair < NPAIR) { const size_t wb = WBASE(pair); rwR = WLD(Rp, wb); rwK = WLD(Kp, wb); rwV = WLD(Vp, wb); rwW = WLD(WP, wb); rwA = WLD(AP, wb); if (j) { rwG = WLD(VG, wb); rwF = *(const v4u*)(VF + wb); } }
#define RFRAG(ob, row, pitch, q) (*(const LAS bf16x8*)(L + (ob) + (row) * (pitch) + (16 * (q) + 8 * hh) * 2))
    for (; pair < NPAIR; pair += F.G) {
        const int item0 = 2 * pair, bh = item0 / NCH, h = bh % NH;
        const int col = h * 64 + lane;
        const float kkc = a.in[I_KK][(size_t)j * D + col], kac = a.in[I_KA][(size_t)j * D + col], rkc = a.in[I_RK][(size_t)j * D + col];
        float ssr[8], bonr[8];
        { const size_t cofs = (size_t)j * D + h * 64 + 8 * lseg;
          const f32x4 kk0 = ld4(a.in[I_KK] + cofs), kk1 = ld4(a.in[I_KK] + cofs + 4), ka0 = ld4(a.in[I_KA] + cofs), ka1 = ld4(a.in[I_KA] + cofs + 4), rk0 = ld4(a.in[I_RK] + cofs), rk1 = ld4(a.in[I_RK] + cofs + 4);
          const f32x4 kf0 = unb4((v2u){rwK.x, rwK.y}), kf1 = unb4((v2u){rwK.z, rwK.w}), rf0 = unb4((v2u){rwR.x, rwR.y}), rf1 = unb4((v2u){rwR.z, rwR.w}), af0 = unb4((v2u){rwA.x, rwA.y}), af1 = unb4((v2u){rwA.z, rwA.w});
          const f32x4 q0 = kf0 * kk0, q1 = kf1 * kk1;
          const f32x4 kp0 = kf0 * (1.0f + (af0 - 1.0f) * ka0), kp1 = kf1 * (1.0f + (af1 - 1.0f) * ka1);
          const float sr = __builtin_amdgcn_rsqf(fmaxf(sum8_dpp(sq4(q0) + sq4(q1)), 1e-24f)), br = sum8_dpp(sum4(rf0 * kp0 * rk0) + sum4(rf1 * kp1 * rk1));
#pragma unroll
          for (int q = 0; q < 8; ++q) { ssr[q] = __builtin_bit_cast(float, __builtin_amdgcn_readlane(__builtin_bit_cast(int, sr), 8 * q)); bonr[q] = __builtin_bit_cast(float, __builtin_amdgcn_readlane(__builtin_bit_cast(int, br), 8 * q)); }
        }
        unsigned short pr[2][4], pk[2][4], pv[2][4], pw[2][4], pa[2][4];
        { LAS unsigned char* stg = L + 2 * US + w * 2048;
#define UNPACK(raw, arr, bs) do { *(LAS v4u*)(stg + (bs) * 1024 + lane * 16) = raw; _Pragma("unroll") for (int q = 0; q < 8; ++q) arr[q >> 2][q & 3] = *(const LAS unsigned short*)(stg + (bs) * 1024 + q * 128 + lane * 2); } while (0)
          v4u rwM = rwV;
          if (j) { const f32x4 v0 = unb4((v2u){rwV.x, rwV.y}), v1 = unb4((v2u){rwV.z, rwV.w}), f0 = unb4((v2u){rwF.x, rwF.y}), f1 = unb4((v2u){rwF.z, rwF.w}), g0 = unb4((v2u){rwG.x, rwG.y}), g1 = unb4((v2u){rwG.z, rwG.w});
                   const f32x4 m0 = v0 + (f0 - v0) * g0, m1 = v1 + (f1 - v1) * g1; rwM = (v4u){pk2(m0[0], m0[1]), pk2(m0[2], m0[3]), pk2(m1[0], m1[1]), pk2(m1[2], m1[3])}; }
          UNPACK(rwR, pr, 0); UNPACK(rwK, pk, 1); UNPACK(rwM, pv, 0); UNPACK(rwW, pw, 1); UNPACK(rwA, pa, 0);
#undef UNPACK
        }
        float aa[2][4], lw[2][4], kkn[2][4], kp[2][4], rr[2][4], cum[2][4], vv[2][4];
#pragma unroll
        for (int u = 0; u < 2; ++u) { LAS unsigned char* Lu = L + u * US;
#pragma unroll
            for (int i = 0; i < 4; ++i) { const int t = 4 * w + i;
                aa[u][i] = BF2F(pa[u][i]); lw[u][i] = BF2F(pw[u][i]);
                const float kraw = BF2F(pk[u][i]); rr[u][i] = BF2F(pr[u][i]);
                vv[u][i] = BF2F(pv[u][i]);
                const float kk = kraw * kkc;
                kkn[u][i] = kk * ssr[u * 4 + i];
                kp[u][i] = kraw * (1.0f + (aa[u][i] - 1.0f) * kac);
                if (lane == 0) ((LAS float*)(Lu + IM_BON))[t] = bonr[u * 4 + i];
            }
            cum[u][0] = lw[u][0]; cum[u][1] = cum[u][0] + lw[u][1]; cum[u][2] = cum[u][1] + lw[u][2]; cum[u][3] = cum[u][2] + lw[u][3];
            ((LAS float*)(Lu + PO_TOT))[w * 64 + lane] = cum[u][3];
        }
        __syncthreads();
        const size_t nwb = WBASE((pair + F.G < NPAIR) ? pair + F.G : pair);
#pragma unroll
        for (int u = 0; u < 2; ++u) { LAS unsigned char* Lu = L + u * US;
            float off = 0.f, tot = 0.f;
#pragma unroll
            for (int ww = 0; ww < 8; ++ww) { const float tv = ((const LAS float*)(Lu + PO_TOT))[ww * 64 + lane]; tot += tv; if (ww < w) off += tv; }
            const float gL = fexp(tot); float bgv[4], kgv[4]; float gprev = fexp(off);
#pragma unroll
            for (int i = 0; i < 4; ++i) { const int t = 4 * w + i; const float cm = off + cum[u][i];
                { constexpr int st = 0; const int sidx = u * 4 + i; (void)st;
                  if (sidx == 0) rwR = WLD(Rp, nwb); else if (sidx == 1) rwK = WLD(Kp, nwb); else if (sidx == 2) rwV = WLD(Vp, nwb); else if (sidx == 3) rwW = WLD(WP, nwb); else if (sidx == 4) rwA = WLD(AP, nwb);
                  else if (sidx == 5) { if (j) rwG = WLD(VG, nwb); } else if (sidx == 6) { if (j) rwF = *(const v4u*)(VF + nwb); }
                  __builtin_amdgcn_sched_barrier(0); }
                const float gam = fexp(cm), ginv = __builtin_amdgcn_rcpf(gam), gl = gL * ginv;
                *(LAS bf16*)(Lu + IM_AT + t * P64 + lane * 2) = bf1(-kkn[u][i] * gprev);
                *(LAS bf16*)(Lu + PO_BT + t * P64 + lane * 2) = bf1(kkn[u][i] * aa[u][i] * ginv);
                *(LAS bf16*)(Lu + PO_KT + t * P64 + lane * 2) = bf1(kp[u][i] * ginv);
                *(LAS bf16*)(Lu + IM_RT + t * P64 + lane * 2) = bf1(rr[u][i] * gam);
                bgv[i] = kkn[u][i] * aa[u][i] * gl; kgv[i] = kp[u][i] * gl; gprev = gam; }
            *(LAS v2u*)(Lu + IM_BGT + lane * P32 + 8 * w) = (v2u){pk2(bgv[0], bgv[1]), pk2(bgv[2], bgv[3])};
            *(LAS v2u*)(Lu + IM_KGT + lane * P32 + 8 * w) = (v2u){pk2(kgv[0], kgv[1]), pk2(kgv[2], kgv[3])};
            *(LAS v2u*)(Lu + IM_VT + lane * P32 + 8 * w) = (v2u){pk2(vv[u][0], vv[u][1]), pk2(vv[u][2], vv[u][3])};
            if (w == 0) ((LAS float*)(Lu + IM_GL))[lane] = gL;
        }
        __syncthreads();
        {
            const int ub = (w >> 2) * US, wq = w & 3;
            f32x16 acc;
#pragma unroll
            for (int i = 0; i < 16; ++i) acc[i] = 0.f;
            const int oa = ub + ((wq < 2) ? IM_AT : IM_RT), ob = ub + ((wq & 1) ? PO_KT : PO_BT);
#pragma unroll
            for (int q = 0; q < 4; ++q) acc = __builtin_amdgcn_mfma_f32_32x32x16_bf16(RFRAG(oa, r, P64, q), RFRAG(ob, r, P64, q), acc, 0, 0, 0);
            const int om = ub + ((wq == 1) ? IM_MAK : ((wq == 2) ? IM_MRB : IM_MRK));
#pragma unroll
            for (int i = 0; i < 16; ++i) { const int t = (i & 3) + 8 * (i >> 2) + 4 * hh; const bool keep = (wq < 2) ? (r < t) : (r <= t); const float val = keep ? acc[i] : 0.f;
                if (wq == 0) ((LAS float*)(L + ub + PO_MAB))[t * 32 + r] = val; else *(LAS bf16*)(L + om + t * P32 + r * 2) = bf1(val); }
        }
        __syncthreads();
        unsigned char* img = IMG + (size_t)item0 * IMG_BYTES;
        if (w < 2) {
            LAS unsigned char* Lu = L + w * US;
            LAS float* TL = (LAS float*)(Lu + PO_TL); const LAS float* MB = (const LAS float*)(Lu + PO_MAB);
#pragma unroll
            for (int rb = 0; rb < 4; ++rb) {
                float acc[8];
#pragma unroll
                for (int e = 0; e < 8; ++e) acc[e] = (8 * rb + e == r) ? 1.f : 0.f;
#pragma unroll
                for (int s4 = 0; s4 < 2 * rb; ++s4) {
                    const float t0 = TL[(4 * s4 + 0) * 32 + r], t1 = TL[(4 * s4 + 1) * 32 + r], t2 = TL[(4 * s4 + 2) * 32 + r], t3 = TL[(4 * s4 + 3) * 32 + r];
#pragma unroll
                    for (int e = 0; e < 8; ++e) { const f32x4 m = *(const LAS f32x4*)(MB + (8 * rb + e) * 32 + 4 * s4); acc[e] += (m[0] * t0 + m[1] * t1) + (m[2] * t2 + m[3] * t3); }
                }
#pragma unroll
                for (int e = 1; e < 8; ++e) { const f32x4 m0 = *(const LAS f32x4*)(MB + (8 * rb + e) * 32 + 8 * rb), m1 = *(const LAS f32x4*)(MB + (8 * rb + e) * 32 + 8 * rb + 4);
#pragma unroll
                    for (int e2 = 0; e2 < e; ++e2) acc[e] += (e2 < 4 ? m0[e2 & 3] : m1[e2 & 3]) * acc[e2]; }
                if (hh == 0) {
#pragma unroll
                    for (int e = 0; e < 8; ++e) { TL[(8 * rb + e) * 32 + r] = acc[e]; *(LAS bf16*)(Lu + IM_T + (8 * rb + e) * P32 + r * 2) = bf1(acc[e]); } }
                LDS_WAIT();
            }
        } else {
            for (int p = F.tid - 128; p < 2 * IMG_PIECES; p += (NWAVES - 2) * 64) { const int u = p >= IMG_PIECES, pp = p - u * IMG_PIECES;
                if (pp < T_PIECE0 || pp >= T_PIECE0 + T_PIECES) __builtin_nontemporal_store(*(const LAS v4u*)(L + u * US + pp * 16), (v4u*)(img + (size_t)u * IMG_BYTES + (size_t)pp * 16)); }
        }
        __syncthreads();
        for (int p = F.tid; p < 2 * T_PIECES; p += NWAVES * 64) { const int u = p >= T_PIECES, pp = T_PIECE0 + p - u * T_PIECES; __builtin_nontemporal_store(*(const LAS v4u*)(L + u * US + pp * 16), (v4u*)(img + (size_t)u * IMG_BYTES + (size_t)pp * 16)); }
        __syncthreads();
    }
#undef RFRAG
#undef WBASE
#undef WLD
#undef BF2F
}
__device__ __forceinline__ float sum16_dpp(float x) {
    x += __builtin_bit_cast(float, __builtin_amdgcn_update_dpp(0, __builtin_bit_cast(int, x), 0xB1, 0xF, 0xF, true));
    x += __builtin_bit_cast(float, __builtin_amdgcn_update_dpp(0, __builtin_bit_cast(int, x), 0x4E, 0xF, 0xF, true));
    x += __builtin_bit_cast(float, __builtin_amdgcn_update_dpp(0, __builtin_bit_cast(int, x), 0x141, 0xF, 0xF, true));
    x += __builtin_bit_cast(float, __builtin_amdgcn_update_dpp(0, __builtin_bit_cast(int, x), 0x140, 0xF, 0xF, true));
    return x;
}
__device__ __forceinline__ void rec_chain(const Args& a, Frame& F, int j) {
    using namespace rc;
    constexpr int IB1 = IMG_BYTES, XO = 2 * IMG_BYTES - IMG_BYTES;
    static_assert(CO_END + XO <= RING_BYTES, "rec_chain LDS map (two image buffers)");
    for (int item = blockIdx.x; item < BATCH * NH; item += F.G) {
    const int b = item / NH, h = item % NH, lane = F.lane, w = F.wave, r = lane & 31, hh = lane >> 5, vh = w & 1;
    LAS unsigned char* L = F.lds;
    const int col = h * 64 + lane;
    const int ett = F.tid >> 4, ecq = F.tid & 15, ecol = h * 64 + 4 * ecq;
    const f32x4 lnw4 = ld4(a.in[I_LNW] + (size_t)j * D + ecol), lnb4 = ld4(a.in[I_LNB] + (size_t)j * D + ecol);
    const unsigned char* IMG = a.ws + WS_IMG + (size_t)item * NCH * IMG_BYTES;
    bf16* YG = (bf16*)(a.ws + WS_YG);
    for (int i = F.tid; i < 64 * P64 / 4; i += NWAVES * 64) ((LAS unsigned*)(L + CO_S + XO))[i] = 0u;
    f32x16 accS;
#pragma unroll
    for (int i = 0; i < 16; ++i) accS[i] = 0.f;
    v4u pre[6];
#pragma unroll
    for (int k = 0; k < 6; ++k) { const int p = F.tid + k * NWAVES * 64; if (p < IMG_PIECES) *(LAS v4u*)(L + p * 16) = *(const v4u*)(IMG + (size_t)p * 16); }
#pragma unroll
    for (int k = 0; k < 6; ++k) { const int p = F.tid + k * NWAVES * 64; pre[k] = (p < IMG_PIECES) ? __builtin_nontemporal_load((const v4u*)(IMG + (size_t)IMG_BYTES + (size_t)p * 16)) : (v4u){0u, 0u, 0u, 0u}; }
    __syncthreads();
#define RFRAG(ob, row, pitch, q) (*(const LAS bf16x8*)(L + (ob) + (row) * (pitch) + (16 * (q) + 8 * hh) * 2))
    const bf16* GPc = (const bf16*)(a.ws + WS_LO) + (size_t)2 * M * D + (size_t)(b * T + ett) * D + ecol;
    v2u gcur = *(const v2u*)GPc;
    const size_t eofs = (size_t)(b * T + ett) * D + ecol;
    const bf16* VPc = (const bf16*)(a.ws + (j ? WS_V1 : WS_V0)) + eofs; const bf16* VFc = (const bf16*)(a.ws + WS_V0) + eofs; const bf16* VGc = (const bf16*)(a.ws + WS_LO) + (size_t)(j ? 3 : 2) * M * D + eofs;
    v2u vcur = *(const v2u*)VPc, vfcur = *(const v2u*)VFc, vgcur = *(const v2u*)VGc;
    for (int c = 0; c < NCH; ++c) {
        const int ib = (c & 1) * IB1, ibn = IB1 - ib;
        const size_t nofs = (size_t)((c + 1 < NCH) ? c + 1 : c) * CL * D;
        const v2u gnext = *(const v2u*)(GPc + nofs), vnext = *(const v2u*)(VPc + nofs), vfnext = *(const v2u*)(VFc + nofs), vgnext = *(const v2u*)(VGc + nofs);
        f32x16 accWY;
#pragma unroll
        for (int i = 0; i < 16; ++i) accWY[i] = 0.f;
        if (w >= 4) {
            const int oa = ib + ((w < 6) ? IM_AT : IM_RT), om = ib + ((w < 6) ? IM_MAK : IM_MRK);
#pragma unroll
            for (int q = 0; q < 4; ++q) accWY = __builtin_amdgcn_mfma_f32_32x32x16_bf16(RFRAG(oa, r, P64, q), RFRAG(CO_S + XO, 32 * vh + r, P64, q), accWY, 0, 0, 0);
#pragma unroll
            for (int q = 0; q < 2; ++q) accWY = __builtin_amdgcn_mfma_f32_32x32x16_bf16(RFRAG(om, r, P32, q), RFRAG(ib + IM_VT, 32 * vh + r, P32, q), accWY, 0, 0, 0);
            if (w < 6) {
#pragma unroll
                for (int g = 0; g < 4; ++g) *(LAS v2u*)(L + CO_WT + XO + (32 * vh + r) * P32 + (8 * g + 4 * hh) * 2) = (v2u){pk2(accWY[4 * g], accWY[4 * g + 1]), pk2(accWY[4 * g + 2], accWY[4 * g + 3])}; }
        }
        __syncthreads();
        if (c + 1 < NCH) {
#pragma unroll
            for (int k = 0; k < 6; ++k) { const int p = F.tid + k * NWAVES * 64; if (p < IMG_PIECES) *(LAS v4u*)(L + ibn + p * 16) = pre[k]; } }
        if (c + 2 < NCH) { const unsigned char* nx = IMG + (size_t)(c + 2) * IMG_BYTES;
#pragma unroll
            for (int k = 0; k < 6; ++k) { const int p = F.tid + k * NWAVES * 64; if (p < IMG_PIECES) pre[k] = __builtin_nontemporal_load((const v4u*)(nx + (size_t)p * 16)); } }
        if (w == 4 || w == 5) {
            f32x16 accU;
#pragma unroll
            for (int i = 0; i < 16; ++i) accU[i] = 0.f;
#pragma unroll
            for (int q = 0; q < 2; ++q) accU = __builtin_amdgcn_mfma_f32_32x32x16_bf16(RFRAG(ib + IM_T, r, P32, q), RFRAG(CO_WT + XO, 32 * vh + r, P32, q), accU, 0, 0, 0);
#pragma unroll
            for (int g = 0; g < 4; ++g) *(LAS v2u*)(L + CO_UT + XO + (32 * vh + r) * P32 + (8 * g + 4 * hh) * 2) = (v2u){pk2(accU[4 * g], accU[4 * g + 1]), pk2(accU[4 * g + 2], accU[4 * g + 3])};
        }
        __syncthreads();
        if (w < 4) {
            const int kh = w >> 1;
#pragma unroll
            for (int i = 0; i < 16; ++i) accS[i] *= ((const LAS float*)(L + ib + IM_GL))[32 * kh + (i & 3) + 8 * (i >> 2) + 4 * hh];
#pragma unroll
            for (int q = 0; q < 2; ++q) { accS = __builtin_amdgcn_mfma_f32_32x32x16_bf16(RFRAG(ib + IM_BGT, 32 * kh + r, P32, q), RFRAG(CO_UT + XO, 32 * vh + r, P32, q), accS, 0, 0, 0);
                                          accS = __builtin_amdgcn_mfma_f32_32x32x16_bf16(RFRAG(ib + IM_KGT, 32 * kh + r, P32, q), RFRAG(ib + IM_VT, 32 * vh + r, P32, q), accS, 0, 0, 0); }
#pragma unroll
            for (int g = 0; g < 4; ++g) *(LAS v2u*)(L + CO_S + XO + (32 * vh + r) * P64 + (32 * kh + 8 * g + 4 * hh) * 2) = (v2u){pk2(accS[4 * g], accS[4 * g + 1]), pk2(accS[4 * g + 2], accS[4 * g + 3])};
        } else if (w >= 6) {
#pragma unroll
            for (int q = 0; q < 2; ++q) accWY = __builtin_amdgcn_mfma_f32_32x32x16_bf16(RFRAG(ib + IM_MRB, r, P32, q), RFRAG(CO_UT + XO, 32 * vh + r, P32, q), accWY, 0, 0, 0);
#pragma unroll
            for (int i = 0; i < 16; ++i) ((LAS float*)(L + CO_YL + XO))[((i & 3) + 8 * (i >> 2) + 4 * hh) * 64 + 32 * vh + r] = accWY[i];
        }
        __syncthreads();
        { const f32x4 y4 = *(const LAS f32x4*)(L + CO_YL + XO + (ett * 64 + 4 * ecq) * 4);
          const v2u ggr = gcur; v2u vvr;
          { const f32x4 vr = unb4(vcur); const f32x4 vm = j ? vr + (unb4(vfcur) - vr) * unb4(vgcur) : vr; vvr = (v2u){pk2(vm[0], vm[1]), pk2(vm[2], vm[3])}; }
          const float bon = ((const LAS float*)(L + ib + IM_BON))[ett];
          const float mean = sum16_dpp(sum4(y4)) * (1.0f / 64.0f); const f32x4 d = y4 - mean;
          const float rstd = __builtin_amdgcn_rsqf(sum16_dpp(sq4(d)) * (1.0f / 64.0f) + GN_EPS);
          const f32x4 vv4 = (f32x4){__uint_as_float(vvr.x << 16), __uint_as_float(vvr.x & 0xffff0000u), __uint_as_float(vvr.y << 16), __uint_as_float(vvr.y & 0xffff0000u)};
          const f32x4 gg4 = (f32x4){__uint_as_float(ggr.x << 16), __uint_as_float(ggr.x & 0xffff0000u), __uint_as_float(ggr.y << 16), __uint_as_float(ggr.y & 0xffff0000u)};
          const f32x4 o4 = (d * rstd * lnw4 + lnb4 + vv4 * bon) * gg4;
          *(v2u*)(YG + ((size_t)(b * T + c * CL + ett)) * D + ecol) = (v2u){pk2(o4[0], o4[1]), pk2(o4[2], o4[3])}; }
        gcur = gnext; vcur = vnext; vfcur = vfnext; vgcur = vgnext;
    }
#undef RFRAG
    __syncthreads();
    }
}

__device__ __forceinline__ float swap_lo(float x) { const unsigned u = __builtin_bit_cast(unsigned, x); auto rr = __builtin_amdgcn_permlane32_swap(u, u, false, false); return __builtin_bit_cast(float, (unsigned)rr[0]); }
__device__ __forceinline__ float swap_hi(float x) { const unsigned u = __builtin_bit_cast(unsigned, x); auto rr = __builtin_amdgcn_permlane32_swap(u, u, false, false); return __builtin_bit_cast(float, (unsigned)rr[1]); }
#define S5_RSTD_PRELUDE() float* RSTD = (float*)(a.ws + WS_Z); do { \
    for (int row = F.gw; row < M; row += F.NGW) { const float sv = wave_sum_dpp(ssp[(size_t)row * SSPW + F.lane]); if (F.lane == 0) RSTD[row] = __builtin_amdgcn_rsqf(sv * (1.0f / D) + RMS_EPS); } \
    xcd_barrier(bar); } while (0)
__device__ __forceinline__ void s5_scan(const Args& a, Frame& F, int j, int li, const XcdBarrier& bar) {
    const bf16* X = (const bf16*)(a.ws + WS_XB); const float* ssp = (const float*)(a.ws + WS_SSP); bf16* YG = (bf16*)(a.ws + WS_YG);
    constexpr int NT = T / 32, NIT = BATCH * (G5 / 4);
    S5_RSTD_PRELUDE();
    for (int item = blockIdx.x; item < NIT; item += F.G) {
    const int b = item / (G5 / 4), g4 = item % (G5 / 4), lane = F.lane;
    LAS float* RS = (LAS float*)F.lds;
    for (int t = 4 * F.tid; t < T; t += NWAVES * 256) *(LAS f32x4*)(RS + t) = ld4(RSTD + (size_t)b * T + t);
    __syncthreads();
    const int pr = F.wave & 3, role = F.wave >> 2;
    const int g = 4 * g4 + pr, s = lane & 31, hh = lane >> 5, cc = lane & 15, kq = lane >> 4;
    LAS unsigned char* XI = F.lds + 32768 + pr * (2 * 8704);
    const float* gmp = a.in[I_MIX_NORM] + (size_t)li * D + 16 * g;
    if (role == 0) {
        const float dt = expf(a.in[I_LSTEP][j * G5 + g]);
        float abr[2], abi[2]; bf16x8 Bf[2][2];
#pragma unroll
        for (int bk = 0; bk < 2; ++bk) {
            const int p = s + 32 * bk; const size_t pi = (size_t)(j * G5 + g) * P5 + p;
            const float lr = fminf(a.in[I_LRE][pi], -1e-4f), lim = a.in[I_LIM][pi], zr = lr * dt, zi = lim * dt;
            const float mag = expf(zr), sn = sinf(zi), cs = cosf(zi), sh = sinf(0.5f * zi), em1 = expm1f(zr);
            abr[bk] = mag * cs; abi[bk] = mag * sn;
            const float am1 = em1 * cs - 2.0f * sh * sh, den = lr * lr + lim * lim;
            const float qr = (am1 * lr + abi[bk] * lim) / den, qi = (abi[bk] * lr - am1 * lim) / den;
            const float* br = a.in[I_BRE] + pi * C5 + 8 * hh; const float* bi = a.in[I_BIM] + pi * C5 + 8 * hh;
            const f32x4 br0 = ld4(br), br1 = ld4(br + 4), bi0 = ld4(bi), bi1 = ld4(bi + 4);
            Bf[bk][0] = pack8(br0 * qr - bi0 * qi, br1 * qr - bi1 * qi);
            Bf[bk][1] = pack8(bi0 * qr + br0 * qi, bi1 * qr + br1 * qi);
        }
        const f32x4 gA0 = ld4(gmp + 8 * hh), gA1 = ld4(gmp + 8 * hh + 4);
        const int tauA = 16 * ((s >> 2) & 1) + 4 * (s >> 3) + (s & 3);
        const bf16* xA = X + (size_t)(b * T + tauA) * D + 16 * g + 8 * hh;
        float x0r = 0.f, x0i = 0.f, x1r = 0.f, x1i = 0.f;
        v4u ra = *(const v4u*)xA, rb = *(const v4u*)(xA + (size_t)32 * D);
        f32x16 zero16;
#pragma unroll
        for (int i = 0; i < 16; ++i) zero16[i] = 0.f;
#define S5_SCAN16() do { _Pragma("unroll") for (int i = 0; i < 16; ++i) { \
                const float n0r = __builtin_fmaf(-abi[0], x0i, __builtin_fmaf(abr[0], x0r, c00[i])), n0i = __builtin_fmaf(abi[0], x0r, __builtin_fmaf(abr[0], x0i, c01[i])); x0r = n0r; x0i = n0i; c00[i] = n0r; c01[i] = n0i; \
                const float n1r = __builtin_fmaf(-abi[1], x1i, __builtin_fmaf(abr[1], x1r, c10[i])), n1i = __builtin_fmaf(abi[1], x1r, __builtin_fmaf(abr[1], x1i, c11[i])); x1r = n1r; x1i = n1i; c10[i] = n1r; c11[i] = n1i; } } while (0)
#define S5_PROD(k_, R) do { \
                const int t0 = 32 * (k_); const float rsA = RS[t0 + tauA]; \
                const bf16x8 af = pack8(unb4((v2u){R.x, R.y}) * rsA * gA0, unb4((v2u){R.z, R.w}) * rsA * gA1); \
                R = *(const v4u*)(xA + (size_t)(((k_) + 2 < NT) ? t0 + 64 : t0) * D); \
                f32x16 c00 = __builtin_amdgcn_mfma_f32_32x32x16_bf16(af, Bf[0][0], zero16, 0, 0, 0), c01 = __builtin_amdgcn_mfma_f32_32x32x16_bf16(af, Bf[0][1], zero16, 0, 0, 0); \
                f32x16 c10 = __builtin_amdgcn_mfma_f32_32x32x16_bf16(af, Bf[1][0], zero16, 0, 0, 0), c11 = __builtin_amdgcn_mfma_f32_32x32x16_bf16(af, Bf[1][1], zero16, 0, 0, 0); \
                if (hh == 0) S5_SCAN16(); \
                x0r = swap_lo(x0r); x0i = swap_lo(x0i); x1r = swap_lo(x1r); x1i = swap_lo(x1i);       \
                if (hh == 1) S5_SCAN16(); \
                x0r = swap_hi(x0r); x0i = swap_hi(x0i); x1r = swap_hi(x1r); x1i = swap_hi(x1i);       \
                LAS unsigned char* XB_ = XI + ((k_) & 1) * 8704; \
                _Pragma("unroll") for (int i = 0; i < 16; ++i) { v2u w; w.x = pk2(c00[i], c01[i]); w.y = pk2(c10[i], c11[i]); *(LAS v2u*)(XB_ + (16 * hh + i) * 272 + 8 * s) = w; } } while (0)
        for (int k = 0; k < NT; k += 2) { S5_PROD(k, ra); __syncthreads(); S5_PROD(k + 1, rb); __syncthreads(); }
        __syncthreads();
#undef S5_PROD
#undef S5_SCAN16
    } else {
        bf16x8 Cf[4];
#pragma unroll
        for (int ks = 0; ks < 4; ++ks) { float cv[8];
#pragma unroll
            for (int e = 0; e < 8; ++e) { const int k = 32 * ks + 8 * kq + e, sp2 = k >> 2, comp = k & 3, p = sp2 + ((comp & 2) ? 32 : 0); const size_t ci = ((size_t)(j * G5 + g) * C5 + cc) * P5 + p;
                cv[e] = (comp & 1) ? -a.in[I_CIM][ci] : a.in[I_CRE][ci]; }
            Cf[ks] = pack8((f32x4){cv[0], cv[1], cv[2], cv[3]}, (f32x4){cv[4], cv[5], cv[6], cv[7]}); }
        const f32x4 gE = ld4(gmp + 4 * kq), dsk = ld4(a.in[I_S5D] + (size_t)j * D + 16 * g + 4 * kq);
        const bf16* xE = X + (size_t)(b * T + cc) * D + 16 * g + 4 * kq;
        bf16* yo = YG + (size_t)(b * T + cc) * D + 16 * g + 4 * kq;
        v2u e0 = *(const v2u*)xE, e1 = *(const v2u*)(xE + (size_t)16 * D), f0 = *(const v2u*)(xE + (size_t)32 * D), f1 = *(const v2u*)(xE + (size_t)48 * D);
#define S5_CONS(k_, E0, E1) do { \
                const int t0 = 32 * ((k_) - 1); const f32x4 ev0 = unb4(E0), ev1 = unb4(E1); \
                { const size_t tn = (size_t)(((k_) + 1 < NT) ? t0 + 64 : t0) * D; E0 = *(const v2u*)(xE + tn); E1 = *(const v2u*)(xE + tn + (size_t)16 * D); } \
                const LAS unsigned char* XB_ = XI + (((k_) - 1) & 1) * 8704; \
                _Pragma("unroll") for (int tb = 0; tb < 2; ++tb) { \
                    f32x4 ay = (f32x4){0.f, 0.f, 0.f, 0.f}; \
                    _Pragma("unroll") for (int ks = 0; ks < 4; ++ks) { const bf16x8 xf = *(const LAS bf16x8*)(XB_ + (16 * tb + cc) * 272 + 64 * ks + 16 * kq); ay = __builtin_amdgcn_mfma_f32_16x16x32_bf16(Cf[ks], xf, ay, 0, 0, 0); } \
                    const f32x4 ev = tb ? ev1 : ev0; const float rsE = RS[t0 + 16 * tb + cc]; \
                    const f32x4 u = ev * rsE * gE; f32x4 yv = ay + dsk * u; \
                    _Pragma("unroll") for (int e = 0; e < 4; ++e) { const float y = yv[e]; yv[e] = y * pg8::fast_sigmoid(1.5957691216f * (y + 0.044715f * y * y * y)); } \
                    v2u w; w.x = pk2(yv[0], yv[1]); w.y = pk2(yv[2], yv[3]); \
                    *(v2u*)(yo + (size_t)(t0 + 16 * tb) * D) = w; } } while (0)
        __syncthreads();
        for (int k = 1; k <= NT; k += 2) { S5_CONS(k, e0, e1); __syncthreads(); S5_CONS(k + 1, f0, f1); __syncthreads(); }
#undef S5_CONS
    }
    }
    if (j == 0 && (int)blockIdx.x >= NIT && F.G > NIT) convert_set(a, F.lane, (LAS float*)(F.lds + F.wave * 16384), 2, ((int)blockIdx.x - NIT) * NWAVES + F.wave, (F.G - NIT) * NWAVES);
}

__device__ __forceinline__ void s5_scan2(const Args& a, Frame& F, int j, int li, const XcdBarrier& bar) {
    const bf16* X = (const bf16*)(a.ws + WS_XB); const float* ssp = (const float*)(a.ws + WS_SSP); bf16* YG = (bf16*)(a.ws + WS_YG);
    constexpr int NT = T / 32, NIT = BATCH * (G5 / 2);
    S5_RSTD_PRELUDE();
    for (int it = blockIdx.x; it < NIT; it += F.G) {
    const int item = (F.G == NIT) ? (it & 7) * (NIT / 8) + (it >> 3) : it;
    const int b = item / (G5 / 2), g2 = item % (G5 / 2), lane = F.lane;
    LAS float* RS = (LAS float*)F.lds;
    for (int t = 4 * F.tid; t < T; t += NWAVES * 256) *(LAS f32x4*)(RS + t) = ld4(RSTD + (size_t)b * T + t);
    __syncthreads();
    const int pr = F.wave & 1, role = (F.wave < 4) ? 0 : ((F.wave < 6) ? 1 : 2), bk = (F.wave >> 1) & 1;
    const int g = 2 * g2 + pr, s = lane & 31, hh = lane >> 5, cc = lane & 15, kq = lane >> 4;
    LAS unsigned char* XI = F.lds + 32768 + pr * (2 * 8704);
    const float* gmp = a.in[I_MIX_NORM] + (size_t)li * D + 16 * g;
    if (role == 0) {
        const float dt = expf(a.in[I_LSTEP][j * G5 + g]);
        float abr, abi; bf16x8 Bf[2];
        {
            const int p = s + 32 * bk; const size_t pi = (size_t)(j * G5 + g) * P5 + p;
            const float lr = fminf(a.in[I_LRE][pi], -1e-4f), lim = a.in[I_LIM][pi], zr = lr * dt, zi = lim * dt;
            const float mag = expf(zr), sn = sinf(zi), cs = cosf(zi), sh = sinf(0.5f * zi), em1 = expm1f(zr);
            abr = mag * cs; abi = mag * sn;
            const float am1 = em1 * cs - 2.0f * sh * sh, den = lr * lr + lim * lim;
            const float qr = (am1 * lr + abi * lim) / den, qi = (abi * lr - am1 * lim) / den;
            const float* br = a.in[I_BRE] + pi * C5 + 8 * hh; const float* bi = a.in[I_BIM] + pi * C5 + 8 * hh;
            const f32x4 br0 = ld4(br), br1 = ld4(br + 4), bi0 = ld4(bi), bi1 = ld4(bi + 4);
            Bf[0] = pack8(br0 * qr - bi0 * qi, br1 * qr - bi1 * qi);
            Bf[1] = pack8(bi0 * qr + br0 * qi, bi1 * qr + br1 * qi);
        }
        const f32x4 gA0 = ld4(gmp + 8 * hh), gA1 = ld4(gmp + 8 * hh + 4);
        const int tauA = 16 * ((s >> 2) & 1) + 4 * (s >> 3) + (s & 3);
        const bf16* xA = X + (size_t)(b * T + tauA) * D + 16 * g + 8 * hh;
        float xr = 0.f, xi = 0.f;
        v4u ra = *(const v4u*)xA, rb = *(const v4u*)(xA + (size_t)32 * D);
        f32x16 zero16;
#pragma unroll
        for (int i = 0; i < 16; ++i) zero16[i] = 0.f;
#define S5_SCAN16H() do { _Pragma("unroll") for (int i = 0; i < 16; ++i) { \
                const float nr = __builtin_fmaf(-abi, xi, __builtin_fmaf(abr, xr, c0[i])), ni = __builtin_fmaf(abi, xr, __builtin_fmaf(abr, xi, c1[i])); xr = nr; xi = ni; c0[i] = nr; c1[i] = ni; } } while (0)
#define S5_PROD(k_, R) do { \
                const int t0 = 32 * (k_); const float rsA = RS[t0 + tauA]; \
                const bf16x8 af = pack8(unb4((v2u){R.x, R.y}) * rsA * gA0, unb4((v2u){R.z, R.w}) * rsA * gA1); \
                R = *(const v4u*)(xA + (size_t)(((k_) + 2 < NT) ? t0 + 64 : t0) * D); \
                f32x16 c0 = __builtin_amdgcn_mfma_f32_32x32x16_bf16(af, Bf[0], zero16, 0, 0, 0), c1 = __builtin_amdgcn_mfma_f32_32x32x16_bf16(af, Bf[1], zero16, 0, 0, 0); \
                if (hh == 0) S5_SCAN16H(); \
                xr = swap_lo(xr); xi = swap_lo(xi);                                     \
                if (hh == 1) S5_SCAN16H(); \
                xr = swap_hi(xr); xi = swap_hi(xi);                                     \
                LAS unsigned char* XB_ = XI + ((k_) & 1) * 8704; \
                _Pragma("unroll") for (int i = 0; i < 16; ++i) *(LAS unsigned*)(XB_ + (16 * hh + i) * 272 + 8 * s + 4 * bk) = pk2(c0[i], c1[i]); } while (0)
        for (int k = 0; k < NT; k += 2) { S5_PROD(k, ra); __syncthreads(); S5_PROD(k + 1, rb); __syncthreads(); }
        __syncthreads();
#undef S5_PROD
#undef S5_SCAN16H
    } else if (role == 1) {
        bf16x8 Cf[4];
#pragma unroll
        for (int ks = 0; ks < 4; ++ks) { float cv[8];
#pragma unroll
            for (int e = 0; e < 8; ++e) { const int k = 32 * ks + 8 * kq + e, sp2 = k >> 2, comp = k & 3, p = sp2 + ((comp & 2) ? 32 : 0); const size_t ci = ((size_t)(j * G5 + g) * C5 + cc) * P5 + p;
                cv[e] = (comp & 1) ? -a.in[I_CIM][ci] : a.in[I_CRE][ci]; }
            Cf[ks] = pack8((f32x4){cv[0], cv[1], cv[2], cv[3]}, (f32x4){cv[4], cv[5], cv[6], cv[7]}); }
        const f32x4 gE = ld4(gmp + 4 * kq), dsk = ld4(a.in[I_S5D] + (size_t)j * D + 16 * g + 4 * kq);
        const bf16* xE = X + (size_t)(b * T + cc) * D + 16 * g + 4 * kq;
        bf16* yo = YG + (size_t)(b * T + cc) * D + 16 * g + 4 * kq;
        v2u e0 = *(const v2u*)xE, e1 = *(const v2u*)(xE + (size_t)16 * D), f0 = *(const v2u*)(xE + (size_t)32 * D), f1 = *(const v2u*)(xE + (size_t)48 * D);
#define S5_CONS(k_, E0, E1) do { \
                const int t0 = 32 * ((k_) - 1); const f32x4 ev0 = unb4(E0), ev1 = unb4(E1); \
                { const size_t tn = (size_t)(((k_) + 1 < NT) ? t0 + 64 : t0) * D; E0 = *(const v2u*)(xE + tn); E1 = *(const v2u*)(xE + tn + (size_t)16 * D); } \
                const LAS unsigned char* XB_ = XI + (((k_) - 1) & 1) * 8704; \
                _Pragma("unroll") for (int tb = 0; tb < 2; ++tb) { \
                    f32x4 ay = (f32x4){0.f, 0.f, 0.f, 0.f}; \
                    _Pragma("unroll") for (int ks = 0; ks < 4; ++ks) { const bf16x8 xf = *(const LAS bf16x8*)(XB_ + (16 * tb + cc) * 272 + 64 * ks + 16 * kq); ay = __builtin_amdgcn_mfma_f32_16x16x32_bf16(Cf[ks], xf, ay, 0, 0, 0); } \
                    const f32x4 ev = tb ? ev1 : ev0; const float rsE = RS[t0 + 16 * tb + cc]; \
                    const f32x4 u = ev * rsE * gE; f32x4 yv = ay + dsk * u; \
                    _Pragma("unroll") for (int e = 0; e < 4; ++e) { const float y = yv[e]; yv[e] = y * pg8::fast_sigmoid(1.5957691216f * (y + 0.044715f * y * y * y)); } \
                    v2u w; w.x = pk2(yv[0], yv[1]); w.y = pk2(yv[2], yv[3]); \
                    *(v2u*)(yo + (size_t)(t0 + 16 * tb) * D) = w; } } while (0)
        __syncthreads();
        for (int k = 1; k <= NT; k += 2) { S5_CONS(k, e0, e1); __syncthreads(); S5_CONS(k + 1, f0, f1); __syncthreads(); }
#undef S5_CONS
    } else {
        for (int k = 0; k <= NT; ++k) __syncthreads();
    }
    }
}

__device__ __forceinline__ void final_norm(const Args& a, Frame& F) {
    const float* ssp = (const float*)(a.ws + WS_SSP); const float* g = a.in[I_FNORM]; const bf16* XB = (const bf16*)(a.ws + WS_XB);
    for (int row = F.gw; row < M; row += F.NGW) {
        const float rs = __builtin_amdgcn_rsqf(wave_sum(ssp[(size_t)row * SSPW + F.lane]) * (1.0f / D) + RMS_EPS);
        float* xo = a.out + (size_t)row * D + 4 * F.lane; const bf16* xi = XB + (size_t)row * D + 4 * F.lane;
#pragma unroll 4
        for (int q = 0; q < 16; ++q) { const f32x4 v = ldb4(xi + 256 * q) * rs * ld4(g + 256 * q + 4 * F.lane); __builtin_nontemporal_store(v, (f32x4*)(xo + 256 * q)); }
    }
}

constexpr int NPH = 82;
#ifndef MK_MULTI
#define MK_MULTI 0
#endif
template <int hl> __device__ __forceinline__ void run_hl(const Args& a, Frame& F, const XcdBarrier& bar) {
#define RUN(k) (a.ph_lo <= (k) && (k) < a.ph_hi)
#define SEAM(k) do { if ((k) + 1 < a.ph_hi) xcd_barrier(bar); } while (0)
    unsigned char* ws = a.ws;
    float* SSP = (float*)(ws + WS_SSP); bf16* XB = (bf16*)(ws + WS_XB); bf16* ACT = (bf16*)(ws + WS_ACT); bf16* YG = (bf16*)(ws + WS_YG);
    const int cid = (int)blockIdx.x;

        constexpr int L = hl >> 1, sidx = hl & 1, base = 1 + hl * 10;
        if (RUN(base)) {
            const int nssp = (sidx == 1 && (L & 1)) ? 128 : 64;
            pg8::Gemm g{XB, (const bf16*)(ws + WS_WIN) + (size_t)hl * 2 * FF * D, M, 2 * FF, D, 1, 0, 0}; pg8::StaticOrder S; S.init(M, 2 * FF, 1, F.G, cid);
            pg8::Unit u0; S.next(0, u0);
            { LAS float* rsl = (LAS float*)(F.lds + RSL_OFF); const int row = u0.pm * 256 + (F.tid >> 1), hf = F.tid & 1; const float* sp = SSP + (size_t)row * SSPW + hf * (nssp >> 1); float s = 0.f;
              for (int q = 0; q < (nssp >> 3); ++q) s += sum4(ld4(sp + 4 * q));
              s += __shfl_xor(s, 1);
              if (hf == 0) rsl[F.tid >> 1] = __builtin_amdgcn_rsqf(s * (1.0f / D) + RMS_EPS);
              __syncthreads(); }
            pg8::EpiSwiglu E{ACT, FF, SSP, nssp, (const LAS float*)(F.lds + RSL_OFF), u0.pm};
            REPX(REP_G1, pg8::gemm_phase<pg8::EpiSwiglu, pg8::StaticOrder, true, true>(F.lds, g, S, E));
            SEAM(base);
        }
        if (RUN(base + 1)) {
            pg8::Gemm g{ACT, (const bf16*)(ws + WS_WOUT) + (size_t)hl * D * FF, M, D, FF, 1, 0, 0}; pg8::StaticOrder S; S.init(M, D, 1, F.G, cid);
            pg8::EpiResid E{XB, SSP, 0.5f};
            { pg8::EpiDry ED{a.out}; REPX(REP_G2DRY, pg8::gemm_phase<pg8::EpiDry, pg8::StaticOrder, true, true>(F.lds, g, S, ED)); }
            pg8::gemm_phase<pg8::EpiResid, pg8::StaticOrder, true, true>(F.lds, g, S, E);
            SEAM(base + 1);
        }
        if constexpr (sidx == 0) {
            constexpr int j = L >> 1;
            if constexpr ((L & 1) == 0) {
                if (RUN(base + 2)) { REPX(REP_RMISC, rwkv_prep(a, F, j, L)); SEAM(base + 2); }
                if (RUN(base + 3)) { {
                    { pg8::Gemm g{(const bf16*)(ws + WS_XR), (const bf16*)(ws + WS_WRKV) + (size_t)j * 3 * D * D, M, D, D, 3, (size_t)M * D, (size_t)D * D}; pg8::StaticOrder S; S.init(M, D, 3, F.G, cid);
                      pg8::EpiAct E{(bf16*)(ws + WS_R), (bf16*)(ws + WS_K), (bf16*)(ws + (j ? WS_V1 : WS_V0)), nullptr, D, nullptr, 0, 0, 0, 0, 0};
                      REPX(REP_RMISC, pg8::gemm_phase<pg8::EpiAct, pg8::StaticOrder, true, true>(F.lds, g, S, E)); }
                    { pg8::Gemm g{(const bf16*)(ws + WS_HB), (const bf16*)(ws + WS_WL1) + (size_t)j * 1024 * D, M, 1024, D, 1, 0, 0}; pg8::StaticOrder S; S.init(M, 1024, 1, F.G, cid);
                      pg8::EpiStore E{(float*)(ws + WS_Z), nullptr, nullptr, nullptr, 1024, nullptr, 0};
                      REPX(REP_RMISC, pg8::gemm_phase<pg8::EpiStore, pg8::StaticOrder, true, true>(F.lds, g, S, E)); }
                    } SEAM(base + 3);
                }
                if (RUN(base + 4)) { REPX(REP_RMISC, rwkv_mid(a, F, j)); SEAM(base + 4); }
                if (RUN(base + 5)) {
                    const int KL = 128 + (F.G >> 20);
                    pg8::Gemm g{(const bf16*)(ws + WS_MID), (const bf16*)(ws + WS_WL2) + (size_t)j * 4 * D * 128, M, D, KL, j ? 4 : 3, (size_t)M * 128, (size_t)D * 128}; pg8::StaticOrder S; S.init(M, D, j ? 4 : 3, F.G, cid);
                    bf16* LO = (bf16*)(ws + WS_LO);
                    pg8::EpiAct E{LO, LO + (size_t)M * D, LO + (size_t)2 * M * D, LO + (size_t)3 * M * D, D, (const float*)(ws + WS_BIAS) + (size_t)j * 4 * D, D, 2, 1, 0, 1};
                    REPX(REP_RMISC, pg8::gemm_phase<pg8::EpiAct, pg8::StaticOrder, true, true>(F.lds, g, S, E));
                    SEAM(base + 5);
                }
                if (RUN(base + 6)) { REPX(REP_PREP, rec_prep(a, F, j)); SEAM(base + 6); }
                if (RUN(base + 7)) { REPX(REP_REC, rec_chain(a, F, j));
                    if ((int)blockIdx.x >= BATCH * NH && F.G > BATCH * NH) convert_set(a, F.lane, (LAS float*)(F.lds + F.wave * 16384), j ? 3 : 1, ((int)blockIdx.x - BATCH * NH) * NWAVES + F.wave, (F.G - BATCH * NH) * NWAVES);
                    SEAM(base + 7); }
                if (RUN(base + 8)) {
                    pg8::Gemm g{YG, (const bf16*)(ws + WS_WO) + (size_t)j * D * D, M, D, D, 1, 0, 0}; pg8::StaticOrder S; S.init(M, D, 1, F.G, cid);
                    pg8::EpiResid E{XB, SSP, 1.0f};
                    { pg8::EpiDry ED{a.out}; REPX(REP_G2DRY, pg8::gemm_phase<pg8::EpiDry, pg8::StaticOrder, true, true>(F.lds, g, S, ED)); }
                    pg8::gemm_phase<pg8::EpiResid, pg8::StaticOrder, true, true>(F.lds, g, S, E);
                    SEAM(base + 8);
                }
            } else {
                if (RUN(base + 2)) { if constexpr (j == 1) { if (F.G >= BATCH * (G5 / 2)) { REPX(REP_S5, s5_scan2(a, F, j, L, bar)); } else { REPX(REP_S5, s5_scan(a, F, j, L, bar)); } } else { REPX(REP_S5, s5_scan(a, F, j, L, bar)); } SEAM(base + 2); }
                if (RUN(base + 3)) {
                    pg8::Gemm g{YG, (const bf16*)(ws + WS_WGLU) + (size_t)j * 2 * D * D, M, 2 * D, D, 1, 0, 0}; pg8::StaticOrder S; S.init(M, 2 * D, 1, F.G, cid);
                    pg8::EpiGluResid E{XB, SSP};
                    { pg8::EpiDry ED{a.out}; REPX(REP_G2DRY, pg8::gemm_phase<pg8::EpiDry, pg8::StaticOrder, true, true>(F.lds, g, S, ED)); }
                    pg8::gemm_phase<pg8::EpiGluResid, pg8::StaticOrder, true, true>(F.lds, g, S, E);
                    SEAM(base + 3);
                }
            }
        }

#undef RUN
#undef SEAM
}
__global__ void __launch_bounds__(NWAVES * 64, 2) fwd(Args a) {
    extern __shared__ __attribute__((aligned(16))) unsigned char lds[];
    Frame F; F.lds = (LAS unsigned char*)lds; F.tid = threadIdx.x; F.lane = F.tid & 63; F.wave = __builtin_amdgcn_readfirstlane(F.tid >> 6);
    F.G = gridDim.x; F.gw = blockIdx.x * NWAVES + F.wave; F.NGW = F.G * NWAVES;
    volatile LAS unsigned* CTLW = (volatile LAS unsigned*)(F.lds + LDSCTL_OFF);
    if (F.tid < 64) CTLW[F.tid] = 0u;
    __syncthreads();
    XcdBarrier bar; bar.bar = (unsigned*)(a.ws + WS_CTL) + CW_BAR; bar.x = 0; bar.st = nullptr;
    const bool multi_phase = (a.ph_hi - a.ph_lo) > 1;
    if (multi_phase) bar = xcd_barrier_post((unsigned*)(a.ws + WS_CTL) + CW_BAR, CTLW + 8);
#define RUN(k) (a.ph_lo <= (k) && (k) < a.ph_hi)
#define SEAM(k) do { if ((k) + 1 < a.ph_hi) xcd_barrier(bar); } while (0)
    unsigned char* ws = a.ws;
    float* SSP = (float*)(ws + WS_SSP); bf16* XB = (bf16*)(ws + WS_XB); bf16* ACT = (bf16*)(ws + WS_ACT); bf16* YG = (bf16*)(ws + WS_YG);
    const int cid = (int)blockIdx.x;

    if (RUN(0)) { REPX(REP_PRO, p0_prologue(a, F)); SEAM(0); }

    run_hl<0>(a, F, bar); run_hl<1>(a, F, bar); run_hl<2>(a, F, bar); run_hl<3>(a, F, bar); run_hl<4>(a, F, bar); run_hl<5>(a, F, bar); run_hl<6>(a, F, bar); run_hl<7>(a, F, bar);
    if (RUN(NPH - 1)) final_norm(a, F);
#undef RUN
#undef SEAM
}

static bool phase_empty(int k) {
    if (k == 0 || k == NPH - 1) return false;
    const int hl = (k - 1) / 10, off = (k - 1) % 10;
    if (off < 2) return false;
    if (hl & 1) return true;
    const int L = hl >> 1;
    if (L & 1) return off >= 4;
    return off >= 9;
}
extern "C" void kernel_launch(void* const* d_in, const int* in_sizes, int n_in, void* d_out, int out_size, void* d_ws, size_t ws_size, hipStream_t stream) {
    static int grid = 0;
    if (grid == 0) {
        if (n_in != 34 || out_size != M * D || ws_size < WS_END) { fprintf(stderr, "kernel_launch: unexpected shapes (n_in %d, out %d, ws %zu < %zu)\n", n_in, out_size, ws_size, (size_t)WS_END); grid = -1; return; }
        int dev = 0, cus = 0, per_cu = 0;
        if (hipGetDevice(&dev) != hipSuccess || hipDeviceGetAttribute(&cus, hipDeviceAttributeMultiprocessorCount, dev) != hipSuccess) { grid = -1; return; }
        if (hipFuncSetAttribute((const void*)fwd, hipFuncAttributeMaxDynamicSharedMemorySize, LDS_BYTES) != hipSuccess) { fprintf(stderr, "kernel_launch: hipFuncSetAttribute failed\n"); grid = -1; return; }
        if (hipOccupancyMaxActiveBlocksPerMultiprocessor(&per_cu, (const void*)fwd, NWAVES * 64, LDS_BYTES) != hipSuccess || per_cu < 1) { fprintf(stderr, "kernel_launch: occupancy query says %d\n", per_cu); }
        (void)hipGetLastError();
        grid = cus;
    }
    if (grid < 0) return;
    (void)hipMemsetAsync((char*)d_ws + WS_CTL, 0, CTL_ZERO_BYTES, stream);
    Args a{};
    for (int i = 0; i < 34; ++i) a.in[i] = (const float*)d_in[i];
    a.out = (float*)d_out; a.ws = (unsigned char*)d_ws;
#if MK_MULTI
    for (int k = 0; k < NPH; ++k) { if (phase_empty(k)) continue; a.ph_lo = k; a.ph_hi = k + 1; hipLaunchKernelGGL(fwd, dim3(grid), dim3(NWAVES * 64), LDS_BYTES, stream, a); }
#else
    a.ph_lo = 0; a.ph_hi = NPH; hipLaunchKernelGGL(fwd, dim3(grid), dim3(NWAVES * 64), LDS_BYTES, stream, a);
#endif
}
```
